# Optimizing an MI355X kernel written in HIP

```python
import math
import jax, jax.numpy as jnp
from jax import lax
import numpy as np

D_MODEL = 1024
BATCH = 8
SEQ = 2048
DEPTH = 2
DEC_BATCH = 8
DEC_SEQ = 32
PAST_LEN = 1024

CHUNK = 64
Q_BLOCK = 128
HEAD_DIM = 64
H_A = 4
H_B = 8
H_C = 4
W_A = H_A * HEAD_DIM
MLA_NOPE = 64
MLA_ROPE = 32
MLA_V = 64
W_B = H_B * MLA_V
W_C = H_C * HEAD_DIM
MIX_WIDTH = W_A + W_B + W_C
Q_LORA = 256
KV_LORA = 128
ROPE_THETA = 10000.0
D_FF = 2816
PLE_DIM = 256
EPS = 1e-6
FFN_RES = 0.5
SB_SCALE = HEAD_DIM ** -0.5
MLA_SCALE = (MLA_NOPE + MLA_ROPE) ** -0.5
FOX_SCALE = HEAD_DIM ** -0.5
A_COLS = 3 * W_A
B_COLS = Q_LORA + KV_LORA + MLA_ROPE
C_COLS = 3 * W_C + H_C
IN_COLS = A_COLS + B_COLS + C_COLS
SPLITS = (W_A, 2 * W_A, 3 * W_A, 3 * W_A + Q_LORA, 3 * W_A + Q_LORA + KV_LORA, A_COLS + B_COLS,
          A_COLS + B_COLS + W_C, A_COLS + B_COLS + 2 * W_C, A_COLS + B_COLS + 3 * W_C)
N_STATE = 7

kernel_name = "hybrid_stream_sb_mla_fox_step"


def rmsnorm(x, g):
    xf = x.astype(jnp.float32)
    y = xf * lax.rsqrt(jnp.mean(xf * xf, axis=-1, keepdims=True) + EPS)
    return (y * g.astype(jnp.float32)).astype(x.dtype)


def swiglu(x, w_gu, w_down):
    g, u = jnp.split(x @ w_gu, 2, axis=-1)
    return (jax.nn.silu(g) * u) @ w_down


def rope(x, pos):
    half = MLA_ROPE // 2
    inv = ROPE_THETA ** (-jnp.arange(half, dtype=jnp.float32) / half)
    ang = pos.astype(jnp.float32)[:, None] * inv[None, :]
    shape = (pos.shape[0],) + (1,) * (x.ndim - 3) + (half,)
    cos, sin = jnp.cos(ang).reshape(shape), jnp.sin(ang).reshape(shape)
    xf = x.astype(jnp.float32)
    x1, x2 = xf[..., :half], xf[..., half:]
    return jnp.concatenate([x1 * cos - x2 * sin, x1 * sin + x2 * cos], axis=-1).astype(x.dtype)


def blockify(a):
    b, s = a.shape[0], a.shape[1]
    return jnp.moveaxis(a.reshape((b, s // Q_BLOCK, Q_BLOCK) + a.shape[2:]), 1, 0)


def unblockify(a):
    a = jnp.moveaxis(a, 0, 1)
    return a.reshape((a.shape[0], a.shape[1] * a.shape[2]) + a.shape[3:])


def stick_breaking(q, k, v, q_pos, k_pos):
    z = jnp.einsum('bqhd,bkhd->bhqk', q, k).astype(jnp.float32) * SB_SCALE
    mask = k_pos[None, :] < q_pos[:, None]
    log_1m = jnp.where(mask, jax.nn.log_sigmoid(-z), 0.0)
    between = lax.cumsum(log_1m, axis=3, reverse=True) - log_1m
    w = jnp.where(mask, jnp.exp(jax.nn.log_sigmoid(z) + between), 0.0)
    return jnp.einsum('bhqk,bkhd->bqhd', w.astype(v.dtype), v)


def chunk_softmax(q, k, v, q_pos, k_pos):
    z = jnp.einsum('bqhd,bkhd->bhqk', q, k).astype(jnp.float32) * MLA_SCALE
    mask = (k_pos // CHUNK)[None, :] <= (q_pos // CHUNK)[:, None]
    pr = jax.nn.softmax(jnp.where(mask, z, -jnp.inf), axis=-1)
    return jnp.einsum('bhqk,bkhd->bqhd', pr.astype(v.dtype), v)


def forgetting(q, k, v, q_pos, k_pos, fq, fk):
    z = jnp.einsum('bqhd,bkhd->bhqk', q, k).astype(jnp.float32) * FOX_SCALE
    z = z + (jnp.swapaxes(fq, 1, 2)[..., :, None] - jnp.swapaxes(fk, 1, 2)[..., None, :])
    mask = k_pos[None, :] <= q_pos[:, None]
    pr = jax.nn.softmax(jnp.where(mask, z, -jnp.inf), axis=-1)
    return jnp.einsum('bhqk,bkhd->bqhd', pr.astype(v.dtype), v)


def token_mix(xn, q_pos, past, w_in, b_f, g_bq, g_bkv, w_uq, w_ukv, g_grp, w_out):
    bsz, t = xn.shape[0], xn.shape[1]
    qa, ka, va, cq, ckv, kr, qc, kc, vc, fl = jnp.split(xn @ w_in, SPLITS, axis=-1)
    qa, ka, va = (a.reshape(bsz, t, H_A, HEAD_DIM) for a in (qa, ka, va))
    qc, kc, vc = (a.reshape(bsz, t, H_C, HEAD_DIM) for a in (qc, kc, vc))
    q_b = (rmsnorm(cq, g_bq) @ w_uq).reshape(bsz, t, H_B, MLA_NOPE + MLA_ROPE)
    q_b = jnp.concatenate([q_b[..., :MLA_NOPE], rope(q_b[..., MLA_NOPE:], q_pos)], axis=-1)
    ckv = rmsnorm(ckv, g_bkv)
    kr = rope(kr, q_pos)
    logf = jax.nn.log_sigmoid((fl + b_f).astype(jnp.float32)).astype(xn.dtype)
    new_state = (ka, va, ckv, kr, kc, vc, logf)
    if past is None:
        ka_all, va_all, ckv_all, kr_all, kc_all, vc_all, logf_all = new_state
        k_pos = q_pos
    else:
        ka_all, va_all, ckv_all, kr_all, kc_all, vc_all, logf_all = [
            jnp.concatenate([c, n.astype(c.dtype)], axis=1) for c, n in zip(past, new_state)]
        k_pos = jnp.arange(past[0].shape[1] + t, dtype=jnp.int32)
    tk = ka_all.shape[1]
    kv_b = (ckv_all @ w_ukv).reshape(bsz, tk, H_B, MLA_NOPE + MLA_V)
    k_b = jnp.concatenate([kv_b[..., :MLA_NOPE],
                           jnp.broadcast_to(kr_all[:, :, None, :], (bsz, tk, H_B, MLA_ROPE)).astype(kv_b.dtype)], axis=-1)
    v_b = kv_b[..., MLA_NOPE:]
    f_all = jnp.cumsum(logf_all.astype(jnp.float32), axis=1)
    f_q = f_all[:, tk - t:]

    def attend(qa_blk, qb_blk, qc_blk, fq_blk, pos_blk):
        return (stick_breaking(qa_blk, ka_all, va_all, pos_blk, k_pos),
                chunk_softmax(qb_blk, k_b, v_b, pos_blk, k_pos),
                forgetting(qc_blk, kc_all, vc_all, pos_blk, k_pos, fq_blk, f_all))

    if past is None:
        oa, ob, oc = lax.map(lambda a: attend(*a),
                             (blockify(qa), blockify(q_b), blockify(qc), blockify(f_q), q_pos.reshape(-1, Q_BLOCK)))
        oa, ob, oc = unblockify(oa), unblockify(ob), unblockify(oc)
    else:
        oa, ob, oc = attend(qa, q_b, qc, f_q, q_pos)
    g_a, g_b, g_c = jnp.split(g_grp, [W_A, W_A + W_B])
    o = jnp.concatenate([rmsnorm(oa.reshape(bsz, t, W_A), g_a),
                         rmsnorm(ob.reshape(bsz, t, W_B), g_b),
                         rmsnorm(oc.reshape(bsz, t, W_C), g_c)], axis=-1)
    return o @ w_out, new_state


def layer(h, p, q_pos, past, g_ff1_pre, g_ff1_post, w_ff1_gu, w_ff1_down, g_mix_pre, g_mix_post, w_in, b_f,
          g_bq, g_bkv, w_uq, w_ukv, g_grp, w_out, g_ff2_pre, g_ff2_post, w_ff2_gu, w_ff2_down,
          g_ple_pre, w_ple_gate, w_ple_proj, g_ple_post):
    h = h + FFN_RES * rmsnorm(swiglu(rmsnorm(h, g_ff1_pre), w_ff1_gu, w_ff1_down), g_ff1_post)
    m, state = token_mix(rmsnorm(h, g_mix_pre), q_pos, past, w_in, b_f, g_bq, g_bkv, w_uq, w_ukv, g_grp, w_out)
    h = h + rmsnorm(m, g_mix_post)
    h = h + FFN_RES * rmsnorm(swiglu(rmsnorm(h, g_ff2_pre), w_ff2_gu, w_ff2_down), g_ff2_post)
    gate = jax.nn.sigmoid(rmsnorm(h, g_ple_pre) @ w_ple_gate)
    h = h + rmsnorm((p @ w_ple_proj) * gate, g_ple_post)
    return h, state


def run_trunk(x, p, q_pos, caches, weights):
    h = x
    per_layer = []
    for i in range(DEPTH):
        lw = [w[i] for w in weights]
        past = None if caches is None else [c[i] for c in caches]
        h, st = layer(h, p[i], q_pos, past, *lw)
        per_layer.append(st)
    stacked = [jnp.stack([st[j] for st in per_layer]) for j in range(N_STATE)]
    return h, stacked


def setup_inputs(seed: int = 0) -> dict:
    key = jax.random.key(seed)
    ks = iter(jax.random.split(key, 48))

    def nrm(shape, scale=1.0):
        return jax.random.normal(next(ks), shape, jnp.float32) * scale

    def gain(width):
        return 1.0 + nrm((DEPTH, width), 0.05)

    d = D_MODEL
    return {
        "x_prompt": nrm((BATCH, SEQ, d)),
        "x_sample": nrm((DEC_BATCH, DEC_SEQ, d)),
        "p_prompt": nrm((DEPTH, BATCH, SEQ, PLE_DIM)),
        "p_sample": nrm((DEPTH, DEC_BATCH, DEC_SEQ, PLE_DIM)),
        "cache_a_k": nrm((DEPTH, DEC_BATCH, PAST_LEN, H_A, HEAD_DIM)),
        "cache_a_v": nrm((DEPTH, DEC_BATCH, PAST_LEN, H_A, HEAD_DIM)),
        "cache_b_ckv": nrm((DEPTH, DEC_BATCH, PAST_LEN, KV_LORA)),
        "cache_b_krope": nrm((DEPTH, DEC_BATCH, PAST_LEN, MLA_ROPE)),
        "cache_c_k": nrm((DEPTH, DEC_BATCH, PAST_LEN, H_C, HEAD_DIM)),
        "cache_c_v": nrm((DEPTH, DEC_BATCH, PAST_LEN, H_C, HEAD_DIM)),
        "cache_c_logf": jax.nn.log_sigmoid(2.0 + nrm((DEPTH, DEC_BATCH, PAST_LEN, H_C))),
        "g_ff1_pre": gain(d),
        "g_ff1_post": gain(d),
        "w_ff1_gu": nrm((DEPTH, d, 2 * D_FF), d ** -0.5),
        "w_ff1_down": nrm((DEPTH, D_FF, d), D_FF ** -0.5),
        "g_mix_pre": gain(d),
        "g_mix_post": gain(d),
        "w_in": nrm((DEPTH, d, IN_COLS), d ** -0.5),
        "b_f": 2.0 + nrm((DEPTH, H_C), 0.1),
        "g_bq": gain(Q_LORA),
        "g_bkv": gain(KV_LORA),
        "w_uq": nrm((DEPTH, Q_LORA, H_B * (MLA_NOPE + MLA_ROPE)), Q_LORA ** -0.5),
        "w_ukv": nrm((DEPTH, KV_LORA, H_B * (MLA_NOPE + MLA_V)), KV_LORA ** -0.5),
        "g_grp": gain(MIX_WIDTH),
        "w_out": nrm((DEPTH, MIX_WIDTH, d), MIX_WIDTH ** -0.5),
        "g_ff2_pre": gain(d),
        "g_ff2_post": gain(d),
        "w_ff2_gu": nrm((DEPTH, d, 2 * D_FF), d ** -0.5),
        "w_ff2_down": nrm((DEPTH, D_FF, d), D_FF ** -0.5),
        "g_ple_pre": gain(d),
        "w_ple_gate": nrm((DEPTH, d, d), d ** -0.5),
        "w_ple_proj": nrm((DEPTH, PLE_DIM, d), PLE_DIM ** -0.5),
        "g_ple_post": gain(d),
    }


def reference(x_prompt, x_sample, p_prompt, p_sample, cache_a_k, cache_a_v, cache_b_ckv, cache_b_krope,
              cache_c_k, cache_c_v, cache_c_logf, g_ff1_pre, g_ff1_post, w_ff1_gu, w_ff1_down,
              g_mix_pre, g_mix_post, w_in, b_f, g_bq, g_bkv, w_uq, w_ukv, g_grp, w_out,
              g_ff2_pre, g_ff2_post, w_ff2_gu, w_ff2_down, g_ple_pre, w_ple_gate, w_ple_proj, g_ple_post):
    weights = (g_ff1_pre, g_ff1_post, w_ff1_gu, w_ff1_down, g_mix_pre, g_mix_post, w_in, b_f,
               g_bq, g_bkv, w_uq, w_ukv, g_grp, w_out, g_ff2_pre, g_ff2_post, w_ff2_gu, w_ff2_down,
               g_ple_pre, w_ple_gate, w_ple_proj, g_ple_post)
    pos_p = jnp.arange(x_prompt.shape[1], dtype=jnp.int32)
    y_prompt, sp = run_trunk(x_prompt, p_prompt, pos_p, None, weights)
    past_len = cache_a_k.shape[2]
    pos_s = past_len + jnp.arange(x_sample.shape[1], dtype=jnp.int32)
    caches = (cache_a_k, cache_a_v, cache_b_ckv, cache_b_krope, cache_c_k, cache_c_v, cache_c_logf)
    y_sample, ss = run_trunk(x_sample, p_sample, pos_s, caches, weights)
    a_k_p, a_v_p, b_ckv_p, b_krope_p, c_k_p, c_v_p, c_logf_p = sp
    a_k_s, a_v_s, b_ckv_s, b_krope_s, c_k_s, c_v_s, c_logf_s = ss
    return (y_prompt, y_sample, a_k_p, a_v_p, b_ckv_p, b_krope_p, c_k_p, c_v_p, c_logf_p,
            a_k_s, a_v_s, b_ckv_s, b_krope_s, c_k_s, c_v_s, c_logf_s)
```

```cpp
#include <hip/hip_runtime.h>
#include <hip/hip_cooperative_groups.h>
#include <cstdio>
#include <cstdint>
namespace cg = cooperative_groups;

#ifndef MEGA
#define MEGA 1
#endif

typedef unsigned short bf16_t;
typedef short bf16x8 __attribute__((ext_vector_type(8)));
typedef short s16x4 __attribute__((ext_vector_type(4)));
typedef float f32x4 __attribute__((ext_vector_type(4)));
typedef unsigned u32x4 __attribute__((ext_vector_type(4)));
typedef unsigned u32x2 __attribute__((ext_vector_type(2)));

#define DI __device__ __forceinline__
#define LAS __attribute__((address_space(3)))

constexpr int DM = 1024, NP = 16384, NS = 256, MT = NP + NS;
constexpr int SEQ = 2048, TS = 32, PAST = 1024, TKS = PAST + TS;
constexpr int KALL = NP + 8 * TKS;
constexpr int DFF = 2816;
constexpr float EPS = 1e-6f;
constexpr float LOG2E = 1.4426950408889634f;

constexpr size_t O_Y = 0;
constexpr size_t O_AKP = (size_t)MT * 1024;
constexpr size_t O_AVP = O_AKP + 8388608;
constexpr size_t O_BCKVP = O_AVP + 8388608;
constexpr size_t O_BKRP = O_BCKVP + 4194304;
constexpr size_t O_CKP = O_BKRP + 1048576;
constexpr size_t O_CVP = O_CKP + 8388608;
constexpr size_t O_CLFP = O_CVP + 8388608;
constexpr size_t O_AKS = O_CLFP + 131072;
constexpr size_t O_AVS = O_AKS + 131072;
constexpr size_t O_BCKVS = O_AVS + 131072;
constexpr size_t O_BKRS = O_BCKVS + 65536;
constexpr size_t O_CKS = O_BKRS + 16384;
constexpr size_t O_CVS = O_CKS + 131072;
constexpr size_t O_CLFS = O_CVS + 131072;

constexpr size_t al256(size_t x) { return (x + 255) & ~(size_t)255; }
constexpr size_t W_GU1 = 0;
constexpr size_t W_DN1 = W_GU1 + (size_t)5632 * 1024 * 2;
constexpr size_t W_IN = W_DN1 + (size_t)1024 * 2816 * 2;
constexpr size_t W_UQ = W_IN + (size_t)2048 * 1024 * 2;
constexpr size_t W_UKV = W_UQ + (size_t)768 * 256 * 2;
constexpr size_t W_OUT = W_UKV + (size_t)1024 * 128 * 2;
constexpr size_t W_GU2 = W_OUT + (size_t)1024 * 1024 * 2;
constexpr size_t W_DN2 = W_GU2 + (size_t)5632 * 1024 * 2;
constexpr size_t W_PG = W_DN2 + (size_t)1024 * 2816 * 2;
constexpr size_t W_PP = W_PG + (size_t)1024 * 1024 * 2;
constexpr size_t W_PBF = W_PP + (size_t)1024 * 256 * 2;
constexpr size_t W_END = W_PBF + (size_t)MT * 256 * 2;
constexpr size_t B_XN = al256(W_END);
constexpr size_t B_ACT = B_XN + (size_t)MT * 1024 * 2;
constexpr size_t B_Y = B_ACT + (size_t)MT * 2816 * 2;
constexpr size_t B_X1 = B_Y + (size_t)MT * 1024 * 4;
constexpr size_t B_QA = B_ACT;
constexpr size_t B_QC = B_QA + (size_t)MT * 256 * 2;
constexpr size_t B_QB = B_QC + (size_t)MT * 256 * 2;
constexpr size_t B_KA = B_QB + (size_t)MT * 768 * 2;
constexpr size_t B_VA = B_KA + (size_t)KALL * 256 * 2;
constexpr size_t B_KC = B_VA + (size_t)KALL * 256 * 2;
constexpr size_t B_VC = B_KC + (size_t)KALL * 256 * 2;
constexpr size_t B_ACT_END = B_VC + (size_t)KALL * 256 * 2;
static_assert(B_ACT_END <= B_Y, "mixer overlay exceeds act region");
constexpr size_t B_SMALL = B_Y;
constexpr size_t B_CQN = B_SMALL + (size_t)MT * 512 * 4;
static_assert(B_CQN + (size_t)MT * 256 * 2 <= B_X1, "Y overlay");
constexpr size_t B_CKVN = B_X1;
constexpr size_t B_KR = B_CKVN + (size_t)KALL * 128 * 2;
constexpr size_t B_F = B_KR + (size_t)KALL * 32 * 2;
constexpr size_t B_KVB = al256(B_F + (size_t)KALL * 4 * 4);
constexpr size_t B_YS = al256(B_KVB + (size_t)KALL * 1024 * 2);
constexpr size_t B_BAR = al256(B_YS + (size_t)11 * NS * 1024 * 4);
constexpr size_t WS_TOTAL = B_BAR + 3456 * 4;

constexpr int LDS_BYTES = 147456;
constexpr int NTHR = 512, NWAVE = 8;

struct Params {
    const float* in[33];
    float* out;
    char* ws;
};

typedef __bf16 bf2_t __attribute__((ext_vector_type(2)));
typedef float f32x2 __attribute__((ext_vector_type(2)));
DI unsigned pk2(float lo, float hi) { const f32x2 v = {lo, hi}; return __builtin_bit_cast(unsigned, __builtin_convertvector(v, bf2_t)); }
DI bf16_t f2bf(float x) { return (bf16_t)(pk2(x, 0.f) & 0xffffu); }
DI float wave_sum(float v) {
#pragma unroll
    for (int o = 32; o >= 1; o >>= 1) v += __shfl_xor(v, o);
    return v;
}
DI void swap16(float x, float& a, float& b) { const auto r = __builtin_amdgcn_permlane16_swap(__float_as_uint(x), __float_as_uint(x), false, false); a = __uint_as_float(r[0]); b = __uint_as_float(r[1]); }
DI void swap32(float x, float& a, float& b) { const auto r = __builtin_amdgcn_permlane32_swap(__float_as_uint(x), __float_as_uint(x), false, false); a = __uint_as_float(r[0]); b = __uint_as_float(r[1]); }
DI float log_sigmoid_f(float x) { return fminf(x, 0.f) - log1pf(expf(-fabsf(x))); }
DI void rope_cs(int pos, int i, float& c, float& s) {
    float inv = exp2f(-(float)i * (13.287712379549449f / 16.0f));
    float rev = (float)pos * inv * 0.15915494309189535f;
    rev -= rintf(rev);
    c = __builtin_amdgcn_cosf(rev);
    s = __builtin_amdgcn_sinf(rev);
}
DI int krow_of(int r) { return r < NP ? r : NP + ((r - NP) >> 5) * TKS + PAST + ((r - NP) & 31); }

DI int wmap(int mode, int n) {
    if (mode == 1) { return n < DFF ? ((n >> 4) * 32 + (n & 15)) : (((n - DFF) >> 4) * 32 + 16 + ((n - DFF) & 15)); }
    if (mode == 2) {
        if (n < 768) return n;
        if (n < 1024) return 1536 + (n - 768);
        if (n < 1152) return 1792 + (n - 1024);
        if (n < 1184) return 1920 + (n - 1152);
        if (n < 1952) return 768 + (n - 1184);
        return n;
    }
    return n;
}

DI void wtile(const float* __restrict__ src, bf16_t* __restrict__ dst, int K, int Nsrc, int mode, int tk, int tn, float* tile, const int tid) {
    const int wave = tid >> 6, lane = tid & 63;
    __syncthreads();
    float4 v[8];
    const int n4 = tn * 256 + lane * 4;
#pragma unroll
    for (int i = 0; i < 8; ++i) {
        const int k = tk * 64 + wave * 8 + i;
        v[i] = make_float4(0.f, 0.f, 0.f, 0.f);
        if (n4 < Nsrc) v[i] = *(const float4*)(src + (size_t)k * Nsrc + n4);
    }
#pragma unroll
    for (int i = 0; i < 8; ++i) *(float4*)(tile + (wave * 8 + i) * 260 + lane * 4) = v[i];
    __syncthreads();
    const int nl = tid & 255, n = tn * 256 + nl;
    if (n < Nsrc) {
        const int dr = wmap(mode, n);
#pragma unroll
        for (int i = 0; i < 4; ++i) {
            const int kc = ((tid >> 8) + 2 * i) * 8;
            const float* t = tile + kc * 260 + nl;
            u32x4 w;
            w.x = pk2(t[0], t[260]); w.y = pk2(t[2 * 260], t[3 * 260]); w.z = pk2(t[4 * 260], t[5 * 260]); w.w = pk2(t[6 * 260], t[7 * 260]);
            *(u32x4*)(dst + (size_t)dr * K + tk * 64 + kc) = w;
        }
    }
}

DI void prep_phase(const Params& p, int l, int bid, int nb, char* smem, const int tid) {
    float* tile = (float*)smem;
    for (int t = bid; t < 1348; t += nb) {
        const float* src; bf16_t* dst; int K, N, mode, base;
        if (t < 352) { src = p.in[13] + (size_t)l * 1024 * 5632; dst = (bf16_t*)(p.ws + W_GU1); K = 1024; N = 5632; mode = 1; base = 0; }
        else if (t < 528) { src = p.in[14] + (size_t)l * 2816 * 1024; dst = (bf16_t*)(p.ws + W_DN1); K = 2816; N = 1024; mode = 0; base = 352; }
        else if (t < 656) { src = p.in[17] + (size_t)l * 1024 * 1956; dst = (bf16_t*)(p.ws + W_IN); K = 1024; N = 1956; mode = 2; base = 528; }
        else if (t < 668) { src = p.in[21] + (size_t)l * 256 * 768; dst = (bf16_t*)(p.ws + W_UQ); K = 256; N = 768; mode = 0; base = 656; }
        else if (t < 676) { src = p.in[22] + (size_t)l * 128 * 1024; dst = (bf16_t*)(p.ws + W_UKV); K = 128; N = 1024; mode = 0; base = 668; }
        else if (t < 740) { src = p.in[24] + (size_t)l * 1024 * 1024; dst = (bf16_t*)(p.ws + W_OUT); K = 1024; N = 1024; mode = 0; base = 676; }
        else if (t < 1092) { src = p.in[27] + (size_t)l * 1024 * 5632; dst = (bf16_t*)(p.ws + W_GU2); K = 1024; N = 5632; mode = 1; base = 740; }
        else if (t < 1268) { src = p.in[28] + (size_t)l * 2816 * 1024; dst = (bf16_t*)(p.ws + W_DN2); K = 2816; N = 1024; mode = 0; base = 1092; }
        else if (t < 1332) { src = p.in[30] + (size_t)l * 1024 * 1024; dst = (bf16_t*)(p.ws + W_PG); K = 1024; N = 1024; mode = 0; base = 1268; }
        else { src = p.in[31] + (size_t)l * 256 * 1024; dst = (bf16_t*)(p.ws + W_PP); K = 256; N = 1024; mode = 0; base = 1332; }
        const int lt = t - base, nkt = K / 64;
        wtile(src, dst, K, N, mode, lt % nkt, lt / nkt, tile, tid);
    }
    {
        bf16_t* win = (bf16_t*)(p.ws + W_IN);
        const int total = (2048 - 1956) * 1024 / 8;
        for (int i = bid * NTHR + tid; i < total; i += nb * NTHR) {
            u32x4 z = {0u, 0u, 0u, 0u};
            *(u32x4*)(win + (size_t)1956 * 1024 + (size_t)i * 8) = z;
        }
    }
    {
        bf16_t* pbf = (bf16_t*)(p.ws + W_PBF);
        const int total = MT * 256 / 8;
        for (int i = bid * NTHR + tid; i < total; i += nb * NTHR) {
            const size_t e = (size_t)i * 8;
            const float* s = (e < (size_t)NP * 256) ? (p.in[2] + (size_t)l * NP * 256 + e) : (p.in[3] + (size_t)l * NS * 256 + (e - (size_t)NP * 256));
            const float4 a = *(const float4*)s, b = *(const float4*)(s + 4);
            u32x4 w; w.x = pk2(a.x, a.y); w.y = pk2(a.z, a.w); w.z = pk2(b.x, b.y); w.w = pk2(b.z, b.w);
            *(u32x4*)(pbf + e) = w;
        }
    }
}

DI void rowpass(const Params& p, bool init, float scale, const float* __restrict__ gpost, const float* __restrict__ gnext, int nparts, int bid, int nb, const int tid) {
    const int wave = __builtin_amdgcn_readfirstlane(tid >> 6), lane = tid & 63;
    float* H = p.out + O_Y;
    const bf16_t* YB = (const bf16_t*)(p.ws + B_Y);
    const float* YS = (const float*)(p.ws + B_YS);
    bf16_t* XN = (bf16_t*)(p.ws + B_XN);
    for (int row = bid * NWAVE + wave; row < MT; row += nb * NWAVE) {
        float4 h[4];
        if (init) {
            const float* x = row < NP ? p.in[0] + (size_t)row * DM : p.in[1] + (size_t)(row - NP) * DM;
#pragma unroll
            for (int i = 0; i < 4; ++i) h[i] = *(const float4*)(x + i * 256 + lane * 4);

        } else {
            float4 y[4];
            float ss = 0.f;
#pragma unroll
            for (int i = 0; i < 4; ++i) h[i] = *(const float4*)(H + (size_t)row * DM + i * 256 + lane * 4);
            if (row < NP) {
                u32x2 yb[4];
#pragma unroll
                for (int i = 0; i < 4; ++i) yb[i] = *(const u32x2*)(YB + (size_t)row * DM + i * 256 + lane * 4);
#pragma unroll
                for (int i = 0; i < 4; ++i) y[i] = make_float4(__uint_as_float(yb[i].x << 16), __uint_as_float(yb[i].x & 0xffff0000u), __uint_as_float(yb[i].y << 16), __uint_as_float(yb[i].y & 0xffff0000u));
            } else {
#pragma unroll
                for (int i = 0; i < 4; ++i) y[i] = make_float4(0.f, 0.f, 0.f, 0.f);
                for (int pt = 0; pt < nparts; ++pt) {
#pragma unroll
                    for (int i = 0; i < 4; ++i) { const float4 u = *(const float4*)(YS + (size_t)pt * NS * DM + (size_t)(row - NP) * DM + i * 256 + lane * 4); y[i].x += u.x; y[i].y += u.y; y[i].z += u.z; y[i].w += u.w; }
                }
            }
#pragma unroll
            for (int i = 0; i < 4; ++i) ss += y[i].x * y[i].x + y[i].y * y[i].y + y[i].z * y[i].z + y[i].w * y[i].w;
            ss = wave_sum(ss);
            const float rs = rsqrtf(ss * (1.0f / DM) + EPS) * scale;
#pragma unroll
            for (int i = 0; i < 4; ++i) {
                const float4 g = *(const float4*)(gpost + i * 256 + lane * 4);
                h[i].x += y[i].x * rs * g.x; h[i].y += y[i].y * rs * g.y; h[i].z += y[i].z * rs * g.z; h[i].w += y[i].w * rs * g.w;
            }
        }
#pragma unroll
        for (int i = 0; i < 4; ++i) *(float4*)(H + (size_t)row * DM + i * 256 + lane * 4) = h[i];
        if (gnext) {
            float s2 = 0.f;
#pragma unroll
            for (int i = 0; i < 4; ++i) s2 += h[i].x * h[i].x + h[i].y * h[i].y + h[i].z * h[i].z + h[i].w * h[i].w;
            s2 = wave_sum(s2);
            const float r2 = rsqrtf(s2 * (1.0f / DM) + EPS);
#pragma unroll
            for (int i = 0; i < 4; ++i) {
                const float4 g = *(const float4*)(gnext + i * 256 + lane * 4);
                u32x2 w; w.x = pk2(h[i].x * r2 * g.x, h[i].y * r2 * g.y); w.y = pk2(h[i].z * r2 * g.z, h[i].w * r2 * g.w);
                *(u32x2*)(XN + (size_t)row * DM + i * 256 + lane * 4) = w;
            }
        }
    }
}

DI void onorm_pass(const Params& p, const float* __restrict__ ggrp, int bid, int nb, const int tid) {
    const int wave = __builtin_amdgcn_readfirstlane(tid >> 6), lane = tid & 63;
    const float* Y = (const float*)(p.ws + B_Y);
    bf16_t* XN = (bf16_t*)(p.ws + B_XN);
    for (int row = bid * NWAVE + wave; row < MT; row += nb * NWAVE) {
        float4 y[4]; float ss[4];
#pragma unroll
        for (int i = 0; i < 4; ++i) {
            y[i] = *(const float4*)(Y + (size_t)row * DM + i * 256 + lane * 4);
            ss[i] = wave_sum(y[i].x * y[i].x + y[i].y * y[i].y + y[i].z * y[i].z + y[i].w * y[i].w);
        }
        const float ra = rsqrtf(ss[0] * (1.0f / 256) + EPS), rb = rsqrtf((ss[1] + ss[2]) * (1.0f / 512) + EPS), rc = rsqrtf(ss[3] * (1.0f / 256) + EPS);
#pragma unroll
        for (int i = 0; i < 4; ++i) {
            const float r = i == 0 ? ra : (i == 3 ? rc : rb);
            const float4 g = *(const float4*)(ggrp + i * 256 + lane * 4);
            u32x2 w; w.x = pk2(y[i].x * r * g.x, y[i].y * r * g.y); w.y = pk2(y[i].z * r * g.z, y[i].w * r * g.w);
            *(u32x2*)(XN + (size_t)row * DM + i * 256 + lane * 4) = w;
        }
    }
}

DI void post_phase(const Params& p, int l, int bid, int nb, const int tid) {
    const int wave = __builtin_amdgcn_readfirstlane(tid >> 6), lane = tid & 63;
    const int gw = bid * NWAVE + wave, nw = nb * NWAVE;
    const float* SM = (const float*)(p.ws + B_SMALL);
    const float* bf_ = p.in[18] + l * 4;
    float* Fall = (float*)(p.ws + B_F);
    for (int sq = (wave == 0 ? bid : 64); sq < 64; sq += nb) {
        const int h = sq & 3, b = (sq >> 2) & 7;
        const float bfh = bf_[h];
        if (sq < 32) {
            float v[32]; float run = 0.f;
#pragma unroll
            for (int j = 0; j < 32; ++j) {
                const int e = lane * 32 + j;
                v[j] = log_sigmoid_f(SM[(size_t)(b * SEQ + e) * 512 + 416 + h] + bfh);
            }
#pragma unroll
            for (int j = 0; j < 32; ++j) { run += v[j]; v[j] = run; }
            float inc = run;
#pragma unroll
            for (int o = 1; o < 64; o <<= 1) { float t = __shfl_up(inc, o); if (lane >= o) inc += t; }
            const float ex = inc - run;
#pragma unroll
            for (int j = 0; j < 32; ++j) Fall[(size_t)(b * SEQ + lane * 32 + j) * 4 + h] = v[j] + ex;
        } else {
            const float* clf = p.in[10] + (size_t)(l * 8 + b) * PAST * 4;
            float v[17]; float run = 0.f;
#pragma unroll
            for (int j = 0; j < 17; ++j) {
                const int e = lane * 17 + j;
                float x = 0.f;
                if (e < PAST) x = clf[e * 4 + h];
                else if (e < TKS) x = log_sigmoid_f(SM[(size_t)(NP + b * TS + (e - PAST)) * 512 + 416 + h] + bfh);
                v[j] = x;
            }
#pragma unroll
            for (int j = 0; j < 17; ++j) { run += v[j]; v[j] = run; }
            float inc = run;
#pragma unroll
            for (int o = 1; o < 64; o <<= 1) { float t = __shfl_up(inc, o); if (lane >= o) inc += t; }
            const float ex = inc - run;
#pragma unroll
            for (int j = 0; j < 17; ++j) { const int e = lane * 17 + j; if (e < TKS) Fall[(size_t)(NP + b * TKS + e) * 4 + h] = v[j] + ex; }
        }
    }
    bf16_t* CQN = (bf16_t*)(p.ws + B_CQN);
    bf16_t* CKVN = (bf16_t*)(p.ws + B_CKVN);
    bf16_t* KR = (bf16_t*)(p.ws + B_KR);
    const float* gbq = p.in[19] + l * 256;
    const float* gbkv = p.in[20] + l * 128;
    for (int r = gw; r < MT; r += nw) {
        const float* s = SM + (size_t)r * 512;
        const int kr = krow_of(r);
        const bool samp = r >= NP;
        const size_t srow = samp ? (size_t)(l * NS + (r - NP)) : (size_t)(l * NP + r);
        {
            const float4 v = *(const float4*)(s + lane * 4);
            const float ss = wave_sum(v.x * v.x + v.y * v.y + v.z * v.z + v.w * v.w);
            const float rs = rsqrtf(ss * (1.0f / 256) + EPS);
            const float4 g = *(const float4*)(gbq + lane * 4);
            u32x2 w; w.x = pk2(v.x * rs * g.x, v.y * rs * g.y); w.y = pk2(v.z * rs * g.z, v.w * rs * g.w);
            *(u32x2*)(CQN + (size_t)r * 256 + lane * 4) = w;
        }
        {
            const float2 v = *(const float2*)(s + 256 + lane * 2);
            const float ss = wave_sum(v.x * v.x + v.y * v.y);
            const float rs = rsqrtf(ss * (1.0f / 128) + EPS);
            const float2 g = *(const float2*)(gbkv + lane * 2);
            const float a = v.x * rs * g.x, b = v.y * rs * g.y;
            float* so = p.out + (samp ? O_BCKVS : O_BCKVP) + srow * 128 + lane * 2;
            *(float2*)so = make_float2(a, b);
            *(unsigned*)(CKVN + (size_t)kr * 128 + lane * 2) = pk2(a, b);
        }
        if (lane < 16) {
            const float x1 = s[384 + lane], x2 = s[400 + lane];
            const int pos = samp ? PAST + ((r - NP) & 31) : (r & (SEQ - 1));
            float c, sn; rope_cs(pos, lane, c, sn);
            const float o1 = x1 * c - x2 * sn, o2 = x1 * sn + x2 * c;
            float* so = p.out + (samp ? O_BKRS : O_BKRP) + srow * 32;
            so[lane] = o1; so[lane + 16] = o2;
            KR[(size_t)kr * 32 + lane] = f2bf(o1); KR[(size_t)kr * 32 + 16 + lane] = f2bf(o2);
        }
        if (lane < 4) {
            const float lf = log_sigmoid_f(s[416 + lane] + bf_[lane]);
            p.out[(samp ? O_CLFS : O_CLFP) + srow * 4 + lane] = lf;
        }
    }
    bf16_t* KA = (bf16_t*)(p.ws + B_KA); bf16_t* VA = (bf16_t*)(p.ws + B_VA);
    bf16_t* KC = (bf16_t*)(p.ws + B_KC); bf16_t* VC = (bf16_t*)(p.ws + B_VC);
    for (int cr = gw; cr < 8 * PAST; cr += nw) {
        const int b = cr >> 10, t = cr & (PAST - 1);
        const size_t crow = (size_t)(l * 8 + b) * PAST + t;
        const size_t kr = (size_t)NP + b * TKS + t;
        {
            const float4 a = *(const float4*)(p.in[4] + crow * 256 + lane * 4);
            u32x2 w; w.x = pk2(a.x, a.y); w.y = pk2(a.z, a.w); *(u32x2*)(KA + kr * 256 + lane * 4) = w;
            const float4 b4 = *(const float4*)(p.in[5] + crow * 256 + lane * 4);
            w.x = pk2(b4.x, b4.y); w.y = pk2(b4.z, b4.w); *(u32x2*)(VA + kr * 256 + lane * 4) = w;
            const float4 c4 = *(const float4*)(p.in[8] + crow * 256 + lane * 4);
            w.x = pk2(c4.x, c4.y); w.y = pk2(c4.z, c4.w); *(u32x2*)(KC + kr * 256 + lane * 4) = w;
            const float4 d4 = *(const float4*)(p.in[9] + crow * 256 + lane * 4);
            w.x = pk2(d4.x, d4.y); w.y = pk2(d4.z, d4.w); *(u32x2*)(VC + kr * 256 + lane * 4) = w;
        }
        {
            const float2 v = *(const float2*)(p.in[6] + crow * 128 + lane * 2);
            *(unsigned*)(CKVN + kr * 128 + lane * 2) = pk2(v.x, v.y);
        }
        if (lane < 16) {
            const float2 v = *(const float2*)(p.in[7] + crow * 32 + lane * 2);
            *(unsigned*)(KR + kr * 32 + lane * 2) = pk2(v.x, v.y);
        }
    }
}

constexpr int LSTR = 72;
struct Ring { int st; int primed; };
DI void gemm_stream2(const bf16_t* __restrict__ A, int lda, const bf16_t* __restrict__ Bt, int ldb, int K, int m0, int n0,
                     const bool has_next, const bf16_t* __restrict__ An, int ldan, const bf16_t* __restrict__ Btn, int ldbn, int m0n, int n0n,
                     char* smem, f32x4 (&acc)[4][4], const int tid, Ring& rg) {
    LAS char* lds = (LAS char*)smem;
    const int wave = __builtin_amdgcn_readfirstlane(tid >> 6), lane = tid & 63, wm = wave >> 1, wn = wave & 1, r = lane & 15, q = lane >> 4;
    const int sc0 = ((lane & 7) ^ (lane >> 4)) * 8, sc1 = ((lane & 7) ^ (4 | (lane >> 4))) * 8;
    const bf16_t* ga = A + (size_t)(m0 + wave * 32 + (lane >> 3)) * lda;
    const bf16_t* gb = Bt + (size_t)(n0 + wave * 16 + (lane >> 3)) * ldb;
    const bf16_t* gan = An + (size_t)(m0n + wave * 32 + (lane >> 3)) * ldan;
    const bf16_t* gbn = Btn + (size_t)(n0n + wave * 16 + (lane >> 3)) * ldbn;
    const unsigned wa = (unsigned)wave * 4096u, wbb = 32768u + (unsigned)wave * 2048u;
#define STAGE(ST, KT) { _Pragma("unroll") for (int i = 0; i < 4; ++i) \
            __builtin_amdgcn_global_load_lds((const unsigned*)(ga + (size_t)i * 8 * lda + (KT) * 64 + ((i & 1) ? sc1 : sc0)), (LAS unsigned*)(lds + (ST) * 49152 + wa + i * 1024), 16, 0, 0); \
        _Pragma("unroll") for (int i = 0; i < 2; ++i) \
            __builtin_amdgcn_global_load_lds((const unsigned*)(gb + (size_t)i * 8 * ldb + (KT) * 64 + ((i & 1) ? sc1 : sc0)), (LAS unsigned*)(lds + (ST) * 49152 + wbb + i * 1024), 16, 0, 0); }
    const int sw = r >> 1;
    const unsigned fo0 = (unsigned)(r * 128 + ((q ^ sw) << 4)), fo1 = (unsigned)(r * 128 + (((q ^ sw) ^ 4) << 4));
    const unsigned aoff = (unsigned)(wm * 64) * 128u, boff = 32768u + (unsigned)(wn * 64) * 128u;
    const int nk = K / 64;
    const int grp = wave >> 2;
#define PIECE(S2, G) { if ((G) < 4) __builtin_amdgcn_global_load_lds((const unsigned*)(pa + (size_t)(G) * 8 * plda + (((G) & 1) ? sc1 : sc0)), (LAS unsigned*)(lds + (S2) * 49152 + wa + (G) * 1024), 16, 0, 0); \
        else __builtin_amdgcn_global_load_lds((const unsigned*)(pb + (size_t)((G) - 4) * 8 * pldb + (((G) & 1) ? sc1 : sc0)), (LAS unsigned*)(lds + (S2) * 49152 + wbb + ((G) - 4) * 1024), 16, 0, 0); }
#define BAR() { __builtin_amdgcn_sched_barrier(0); __builtin_amdgcn_s_barrier(); asm volatile("" ::: "memory"); __builtin_amdgcn_sched_barrier(0); }
    int st = rg.st;
    if (!rg.primed) {
        const int s1p = st == 2 ? 0 : st + 1;
        BAR();
        STAGE(st, 0);
        STAGE(s1p, 1);
        asm volatile("s_waitcnt vmcnt(6)" ::: "memory");
        BAR();
    }
    if (grp == 1) BAR();
    for (int kt = 0; kt < nk; ++kt) {
        const bool pf = (kt + 2 < nk) || has_next, more = (kt + 1 < nk) || has_next;
        const bf16_t* pa = (kt + 2 < nk) ? ga + (kt + 2) * 64 : gan + (kt + 2 - nk) * 64;
        const bf16_t* pb = (kt + 2 < nk) ? gb + (kt + 2) * 64 : gbn + (kt + 2 - nk) * 64;
        const int plda = (kt + 2 < nk) ? lda : ldan, pldb = (kt + 2 < nk) ? ldb : ldbn;
        const int s2 = st >= 1 ? st - 1 : 2;
        const LAS char* base = lds + st * 49152;
#pragma unroll
        for (int ks = 0; ks < 2; ++ks) {
            const unsigned fo = ks ? fo1 : fo0;
            bf16x8 af[4], bfr[4];
#pragma unroll
            for (int i = 0; i < 4; ++i) { af[i] = *(const LAS bf16x8*)(base + aoff + i * 2048 + fo); bfr[i] = *(const LAS bf16x8*)(base + boff + i * 2048 + fo); }
            if (ks == 1 && more) { if (pf) asm volatile("s_waitcnt vmcnt(3)" ::: "memory"); else asm volatile("s_waitcnt vmcnt(0)" ::: "memory"); }
            if (pf) { PIECE(s2, ks * 3 + 0); PIECE(s2, ks * 3 + 1); PIECE(s2, ks * 3 + 2); }
            asm volatile("s_waitcnt lgkmcnt(0)" ::: "memory");
            BAR();
            __builtin_amdgcn_s_setprio(1);
#pragma unroll
            for (int mi = 0; mi < 4; ++mi)
#pragma unroll
                for (int ni = 0; ni < 4; ++ni) acc[mi][ni] = __builtin_amdgcn_mfma_f32_16x16x32_bf16(bfr[ni], af[mi], acc[mi][ni], 0, 0, 0);
            __builtin_amdgcn_s_setprio(0);
            BAR();
        }
        st = st == 2 ? 0 : st + 1;
    }
    if (grp == 0) BAR();
    rg.st = st; rg.primed = has_next ? 1 : 0;
#undef PIECE
#undef BAR
#undef STAGE
}

DI void gemm_stream(const bf16_t* __restrict__ A, int lda, const bf16_t* __restrict__ Bt, int ldb, int K, int m0, int n0, const bool has_next, int m0n, int n0n,
                    char* smem, f32x4 (&acc)[4][4], const int tid, Ring& rg) {
    gemm_stream2(A, lda, Bt, ldb, K, m0, n0, has_next, A, lda, Bt, ldb, m0n, n0n, smem, acc, tid, rg);
}
DI void gemm_mainloop(const bf16_t* __restrict__ A, int lda, const bf16_t* __restrict__ Bt, int ldb, int K, int m0, int n0, char* smem, f32x4 (&acc)[4][4], const int tid) {
    Ring rg; rg.st = 0; rg.primed = 0;
    gemm_stream(A, lda, Bt, ldb, K, m0, n0, false, m0, n0, smem, acc, tid, rg);
}

struct TileIter {
    int L, end, step, ntm, ntn;
    DI void init(int ntm_, int ntn_, int bid, int nb) {
        ntm = ntm_; ntn = ntn_;
        const int nt = ntm * ntn;
        if ((nb & 7) == 0) { const int x = bid & 7, per = (nt + 7) >> 3; L = x * per + (bid >> 3); end = min((x + 1) * per, nt); step = nb >> 3; }
        else { L = bid; end = nt; step = nb; }
    }
    DI bool next(int& tm, int& tn) {
        if (L >= end) return false;
        const int gsz = 8 * ntn, grp = L / gsz, rem = L - grp * gsz, rows = min(8, ntm - grp * 8);
        tn = rem / rows; tm = grp * 8 + (rem - tn * rows);
        L += step; return true;
    }
};

DI void zero_acc(f32x4 (&acc)[4][4]) {
#pragma unroll
    for (int i = 0; i < 4; ++i)
#pragma unroll
        for (int j = 0; j < 4; ++j) acc[i][j] = (f32x4){0.f, 0.f, 0.f, 0.f};
}

DI void gemm_gu(const Params& p, size_t woff, int bid, int nb, char* smem, const int tid) {
    const bf16_t* A = (const bf16_t*)(p.ws + B_XN);
    const bf16_t* Bt = (const bf16_t*)(p.ws + woff);
    bf16_t* ACT = (bf16_t*)(p.ws + B_ACT);
    const int ntn = 44, ntiles = 130 * ntn;
    const int lane = tid & 63, wave = __builtin_amdgcn_readfirstlane(tid >> 6), wm = wave >> 1, wn = wave & 1, r = lane & 15, q = lane >> 4;
    TileIter ti; ti.init(65, ntn, bid, nb);
    int tm, tn, tm2 = 0, tn2 = 0;
    bool have = ti.next(tm, tn);
    Ring rg; rg.st = 0; rg.primed = 0;
    for (; have; tm = tm2, tn = tn2) {
        have = ti.next(tm2, tn2);
        const int m0 = tm * 256, n0 = tn * 128;
        f32x4 acc[4][4]; zero_acc(acc);
        gemm_stream(A, 1024, Bt, 1024, 1024, m0, n0, have, tm2 * 256, tn2 * 128, smem, acc, tid, rg);
        const int nb0 = n0 + wn * 64;
#pragma unroll
        for (int mi = 0; mi < 4; ++mi) {
            const int row = m0 + wm * 64 + mi * 16 + r;
#pragma unroll
            for (int pr = 0; pr < 2; ++pr) {
                const f32x4 g = acc[mi][2 * pr], u = acc[mi][2 * pr + 1];
                float o[4];
#pragma unroll
                for (int j = 0; j < 4; ++j) o[j] = g[j] * __builtin_amdgcn_rcpf(1.0f + __builtin_amdgcn_exp2f(-LOG2E * g[j])) * u[j];
                const int col = ((nb0 + pr * 32) >> 5) * 16 + q * 4;
                u32x2 w; w.x = pk2(o[0], o[1]); w.y = pk2(o[2], o[3]);
                *(u32x2*)(ACT + (size_t)row * DFF + col) = w;
            }
        }
    }
}

template <int MODE>
DI void epi_y(const Params& p, const f32x4 (&acc)[4][4], int m0, int n0, const int tid, const int part = 0) {
    bf16_t* Y = (bf16_t*)(p.ws + B_Y);
    float* YS = (float*)(p.ws + B_YS);
    const int lane = tid & 63, wave = __builtin_amdgcn_readfirstlane(tid >> 6), wm = wave >> 1, wn = wave & 1, r = lane & 15, q = lane >> 4;
#pragma unroll
    for (int mi = 0; mi < 4; ++mi) {
        const int row = m0 + wm * 64 + mi * 16 + r;
#pragma unroll
        for (int ni = 0; ni < 4; ++ni) {
            const int col = n0 + wn * 64 + ni * 16 + q * 4;
            if (MODE == 0) {
                u32x2 w; w.x = pk2(acc[mi][ni][0], acc[mi][ni][1]); w.y = pk2(acc[mi][ni][2], acc[mi][ni][3]);
                *(u32x2*)(Y + (size_t)row * DM + col) = w;
            } else if (MODE == 1) {
                *(f32x4*)(YS + (size_t)(row - NP) * DM + col) = acc[mi][ni];
            } else {
                *(f32x4*)(YS + (size_t)part * NS * DM + (size_t)(row - NP) * DM + col) = acc[mi][ni];
            }
        }
    }
}

DI void gemm_y(const Params& p, const bf16_t* A, int lda, size_t woff, int K, int kper, int bid, int nb, char* smem, const int tid) {
    const bf16_t* Bt = (const bf16_t*)(p.ws + woff);
    TileIter ti; ti.init(64, 8, bid, nb);
    int tm, tn, tm2 = 0, tn2 = 0;
    bool have = ti.next(tm, tn);
    Ring rg; rg.st = 0; rg.primed = 0;
    for (; have; tm = tm2, tn = tn2) {
        have = ti.next(tm2, tn2);
        const int m0 = tm * 256, n0 = tn * 128;
        f32x4 acc[4][4]; zero_acc(acc);
        gemm_stream(A, lda, Bt, K, K, m0, n0, have, tm2 * 256, tn2 * 128, smem, acc, tid, rg);
        epi_y<0>(p, acc, m0, n0, tid);
    }
    const int S = (K / 64) / kper;
    for (int u = bid; u < 8 * S; u += nb) {
        const int tile = u / S, part = u - tile * S, m0 = NP, n0 = tile * 128;
        f32x4 acc[4][4]; zero_acc(acc);
        gemm_mainloop(A + part * kper * 64, lda, Bt + part * kper * 64, K, kper * 64, m0, n0, smem, acc, tid);
        epi_y<2>(p, acc, m0, n0, tid, part);
    }
}

DI void gemm_ple(const Params& p, int bid, int nb, char* smem, const int tid) {
    const bf16_t* XN = (const bf16_t*)(p.ws + B_XN);
    const bf16_t* PB = (const bf16_t*)(p.ws + W_PBF);
    const bf16_t* WG = (const bf16_t*)(p.ws + W_PG);
    const bf16_t* WP = (const bf16_t*)(p.ws + W_PP);
    const int ntn = 8, ntiles = 130 * ntn;
    TileIter ti; ti.init(65, ntn, bid, nb);
    int tm, tn, tm2 = 0, tn2 = 0;
    bool have = ti.next(tm, tn);
    Ring rg; rg.st = 0; rg.primed = 0;
    for (; have; tm = tm2, tn = tn2) {
        have = ti.next(tm2, tn2);
        const int m0 = tm * 256, n0 = tn * 128;
        u32x2 gpk[4][4];
        {
            f32x4 gate[4][4]; zero_acc(gate);
            gemm_stream2(XN, 1024, WG, 1024, 1024, m0, n0, true, PB, 256, WP, 256, m0, n0, smem, gate, tid, rg);
#pragma unroll
            for (int i = 0; i < 4; ++i)
#pragma unroll
                for (int j = 0; j < 4; ++j) {
                    float g[4];
#pragma unroll
                    for (int e = 0; e < 4; ++e) g[e] = __builtin_amdgcn_rcpf(1.0f + __builtin_amdgcn_exp2f(-LOG2E * gate[i][j][e]));
                    gpk[i][j].x = pk2(g[0], g[1]); gpk[i][j].y = pk2(g[2], g[3]);
                }
        }
        f32x4 acc[4][4]; zero_acc(acc);
        gemm_stream2(PB, 256, WP, 256, 256, m0, n0, have, XN, 1024, WG, 1024, tm2 * 256, tn2 * 128, smem, acc, tid, rg);
#pragma unroll
        for (int i = 0; i < 4; ++i)
#pragma unroll
            for (int j = 0; j < 4; ++j) {
                acc[i][j][0] *= __uint_as_float(gpk[i][j].x << 16); acc[i][j][1] *= __uint_as_float(gpk[i][j].x & 0xffff0000u);
                acc[i][j][2] *= __uint_as_float(gpk[i][j].y << 16); acc[i][j][3] *= __uint_as_float(gpk[i][j].y & 0xffff0000u);
            }
        if (m0 < NP) epi_y<0>(p, acc, m0, n0, tid); else epi_y<1>(p, acc, m0, n0, tid);
    }
}

DI void gemm_in(const Params& p, int l, int bid, int nb, char* smem, const int tid) {
    const bf16_t* A = (const bf16_t*)(p.ws + B_XN);
    const bf16_t* Bt = (const bf16_t*)(p.ws + W_IN);
    const int ntn = 16, ntiles = 130 * ntn;
    const int lane = tid & 63, wave = __builtin_amdgcn_readfirstlane(tid >> 6), wm = wave >> 1, wn = wave & 1, r = lane & 15, q = lane >> 4;
    TileIter ti; ti.init(65, ntn, bid, nb);
    int tm, tn, tm2 = 0, tn2 = 0;
    bool have = ti.next(tm, tn);
    Ring rg; rg.st = 0; rg.primed = 0;
    for (; have; tm = tm2, tn = tn2) {
        have = ti.next(tm2, tn2);
        const int m0 = tm * 256, n0 = tn * 128;
        f32x4 acc[4][4]; zero_acc(acc);
        gemm_stream(A, 1024, Bt, 1024, 1024, m0, n0, have, tm2 * 256, tn2 * 128, smem, acc, tid, rg);
        const int nb0 = n0 + wn * 64;
        const int seg = nb0 >> 8;
        const int cin = nb0 & 255;
        if (seg == 0 || seg == 3) {
            bf16_t* Q = (bf16_t*)(p.ws + (seg == 0 ? B_QA : B_QC));
#pragma unroll
            for (int mi = 0; mi < 4; ++mi) {
                const int row = m0 + wm * 64 + mi * 16 + r;
#pragma unroll
                for (int ni = 0; ni < 4; ++ni) {
                    u32x2 w; w.x = pk2(acc[mi][ni][0], acc[mi][ni][1]); w.y = pk2(acc[mi][ni][2], acc[mi][ni][3]);
                    *(u32x2*)(Q + (size_t)row * 256 + cin + ni * 16 + q * 4) = w;
                }
            }
        } else if (seg < 6) {
            const size_t boff = seg == 1 ? B_KA : seg == 2 ? B_VA : seg == 4 ? B_KC : B_VC;
            const bool samp = m0 >= NP;
            const size_t ooff = samp ? (seg == 1 ? O_AKS : seg == 2 ? O_AVS : seg == 4 ? O_CKS : O_CVS) : (seg == 1 ? O_AKP : seg == 2 ? O_AVP : seg == 4 ? O_CKP : O_CVP);
            bf16_t* KV = (bf16_t*)(p.ws + boff);
#pragma unroll
            for (int mi = 0; mi < 4; ++mi) {
                const int row = m0 + wm * 64 + mi * 16 + r;
                const size_t srow = samp ? (size_t)(l * NS + (row - NP)) : (size_t)(l * NP + row);
                const size_t kr = (size_t)krow_of(row);
#pragma unroll
                for (int ni = 0; ni < 4; ++ni) {
                    const int c = cin + ni * 16 + q * 4;
                    *(f32x4*)(p.out + ooff + srow * 256 + c) = acc[mi][ni];
                    u32x2 w; w.x = pk2(acc[mi][ni][0], acc[mi][ni][1]); w.y = pk2(acc[mi][ni][2], acc[mi][ni][3]);
                    *(u32x2*)(KV + kr * 256 + c) = w;
                }
            }
        } else {
            float* SM = (float*)(p.ws + B_SMALL);
#pragma unroll
            for (int mi = 0; mi < 4; ++mi) {
                const int row = m0 + wm * 64 + mi * 16 + r;
#pragma unroll
                for (int ni = 0; ni < 4; ++ni) *(f32x4*)(SM + (size_t)row * 512 + (nb0 - 1536) + ni * 16 + q * 4) = acc[mi][ni];
            }
        }
    }
}

DI void gemm_uqkv(const Params& p, int bid, int nb, char* smem, const int tid) {
    const int lane = tid & 63, wave = __builtin_amdgcn_readfirstlane(tid >> 6), wm = wave >> 1, wn = wave & 1, r = lane & 15, q = lane >> 4;
    const int nuq = 65 * 6, nukv = (KALL / 256) * 8;
    const bf16_t* CQN = (const bf16_t*)(p.ws + B_CQN); const bf16_t* WUQ = (const bf16_t*)(p.ws + W_UQ);
    const bf16_t* CKV = (const bf16_t*)(p.ws + B_CKVN); const bf16_t* WUKV = (const bf16_t*)(p.ws + W_UKV);
    Ring rg; rg.st = 0; rg.primed = 0;
    for (int t = bid; t < nuq + nukv; t += nb) {
        f32x4 acc[4][4]; zero_acc(acc);
        const int t2 = t + nb;
        const bool hn = t2 < nuq + nukv, nuqn = t2 < nuq;
        const int u2 = nuqn ? t2 : t2 - nuq;
        const int m0n = (nuqn ? u2 / 6 : u2 / 8) * 256, n0n = (nuqn ? u2 % 6 : u2 % 8) * 128;
        const bf16_t* An = nuqn ? CQN : CKV; const bf16_t* Btn = nuqn ? WUQ : WUKV; const int ldn = nuqn ? 256 : 128;
        if (t < nuq) {
            const int tm = t / 6, tn = t % 6, m0 = tm * 256, n0 = tn * 128;
            gemm_stream2(CQN, 256, WUQ, 256, 256, m0, n0, hn, An, ldn, Btn, ldn, m0n, n0n, smem, acc, tid, rg);
            bf16_t* QB = (bf16_t*)(p.ws + B_QB);
            const int nb0 = n0 + wn * 64, f0 = nb0 >> 4;
#pragma unroll
            for (int mi = 0; mi < 4; ++mi) {
                const int row = m0 + wm * 64 + mi * 16 + r;
                const int pos = row < NP ? (row & (SEQ - 1)) : PAST + ((row - NP) & 31);
#pragma unroll
                for (int pr = 0; pr < 2; ++pr) {
                    f32x4 a = acc[mi][2 * pr], b = acc[mi][2 * pr + 1];
                    if ((f0 + 2 * pr) % 6 == 4) {
#pragma unroll
                        for (int j = 0; j < 4; ++j) {
                            float c, s; rope_cs(pos, q * 4 + j, c, s);
                            const float x1 = a[j], x2 = b[j];
                            a[j] = x1 * c - x2 * s; b[j] = x1 * s + x2 * c;
                        }
                    }
                    u32x2 w; w.x = pk2(a[0], a[1]); w.y = pk2(a[2], a[3]);
                    *(u32x2*)(QB + (size_t)row * 768 + nb0 + pr * 32 + q * 4) = w;
                    w.x = pk2(b[0], b[1]); w.y = pk2(b[2], b[3]);
                    *(u32x2*)(QB + (size_t)row * 768 + nb0 + pr * 32 + 16 + q * 4) = w;
                }
            }
        } else {
            const int t2 = t - nuq, tm = t2 / 8, tn = t2 % 8, m0 = tm * 256, n0 = tn * 128;
            gemm_stream2(CKV, 128, WUKV, 128, 128, m0, n0, hn, An, ldn, Btn, ldn, m0n, n0n, smem, acc, tid, rg);
            bf16_t* KVB = (bf16_t*)(p.ws + B_KVB);
#pragma unroll
            for (int mi = 0; mi < 4; ++mi) {
                const int row = m0 + wm * 64 + mi * 16 + r;
#pragma unroll
                for (int ni = 0; ni < 4; ++ni) {
                    u32x2 w; w.x = pk2(acc[mi][ni][0], acc[mi][ni][1]); w.y = pk2(acc[mi][ni][2], acc[mi][ni][3]);
                    *(u32x2*)(KVB + (size_t)row * 1024 + n0 + wn * 64 + ni * 16 + q * 4) = w;
                }
            }
        }
    }
}

constexpr int KSTR = 104;
constexpr int VSTR = 68;
struct AttnItem {
    const bf16_t* Q; int ldq;
    const bf16_t* K; int ldk;
    const bf16_t* KR;
    const bf16_t* V; int ldv;
    const float* F;
    float* O;
    int nq, qpos0, Tk, ntiles;
};

template <int MODE, bool MASKED>
DI void attn_scores(const f32x4 (&s)[4], float (&pw)[4][4], const int kt, const int q, const int qpos, const int Tk, const LAS float* sF, const float sc,
                    float& m, float& lsum, float& R, f32x4 (&o)[4]) {
    if (MODE == 0) {
        float e[4][4], hq[4], T[4];
#pragma unroll
        for (int st = 0; st < 4; ++st) {
            float lv[4];
#pragma unroll
            for (int j = 0; j < 4; ++j) {
                const int key = kt * 64 + st * 16 + q * 4 + j;
                const float z = s[st][j] * sc;
                const bool valid = !MASKED || key < qpos;
                lv[j] = valid ? -(fmaxf(z, 0.f) + __logf(1.0f + __expf(-fabsf(z)))) : 0.f;
                pw[st][j] = valid ? z + lv[j] : -1e30f;
            }
            e[st][3] = 0.f; e[st][2] = lv[3]; e[st][1] = lv[3] + lv[2]; e[st][0] = lv[3] + lv[2] + lv[1];
            const float tot = e[st][0] + lv[0];
            float a16, b16, a32, b32;
            swap16(tot, a16, b16);
            const float pr = a16 + b16;
            swap32(pr, a32, b32);
            T[st] = a32 + b32;
            hq[st] = ((q & 1) == 0 ? b16 : 0.f) + ((q & 2) == 0 ? b32 : 0.f);
        }
        float after = 0.f;
#pragma unroll
        for (int st = 3; st >= 0; --st) {
#pragma unroll
            for (int j = 0; j < 4; ++j) {
                const float arg = pw[st][j] + (R + after + hq[st] + e[st][j]);
                pw[st][j] = (!MASKED || pw[st][j] > -1e29f) ? __expf(arg) : 0.f;
            }
            after += T[st];
        }
        R += after;
    } else {
        float mx = -1e30f;
#pragma unroll
        for (int st = 0; st < 4; ++st) {
            f32x4 fv = (f32x4){0.f, 0.f, 0.f, 0.f};
            if (MODE == 2) fv = *(const LAS f32x4*)(sF + st * 16 + q * 4);
#pragma unroll
            for (int j = 0; j < 4; ++j) {
                const int key = kt * 64 + st * 16 + q * 4 + j;
                const bool valid = !MASKED || ((key < Tk) && (MODE == 1 ? ((key >> 6) <= (qpos >> 6)) : (key <= qpos)));
                const float z = s[st][j] * (sc * LOG2E) - fv[j];
                pw[st][j] = valid ? z : -1e30f;
                mx = fmaxf(mx, pw[st][j]);
            }
        }
        { float a, b; swap16(mx, a, b); mx = fmaxf(a, b); swap32(mx, a, b); mx = fmaxf(a, b); }
        const float mn = fmaxf(m, mx);
        const float alpha = __builtin_amdgcn_exp2f(m - mn);
        m = mn;
        float ps = 0.f;
#pragma unroll
        for (int st = 0; st < 4; ++st)
#pragma unroll
            for (int j = 0; j < 4; ++j) {
                const float pv = (!MASKED || pw[st][j] > -1e29f) ? __builtin_amdgcn_exp2f(pw[st][j] - mn) : 0.f;
                pw[st][j] = pv; ps += pv;
            }
        lsum = lsum * alpha + ps;
#pragma unroll
        for (int i = 0; i < 4; ++i) o[i] = o[i] * alpha;
    }
}

template <int MODE>
DI void attn_item(const AttnItem& a, char* smem, const int tid) {
    constexpr int DQK = MODE == 1 ? 96 : 64, NKS = DQK / 32;
    constexpr unsigned KOFF = 0, VOFF = 8192, KROFF = 16384, FOFF = 20480, ASTG = 21504;
    LAS char* lds = (LAS char*)smem;
    const int wave = __builtin_amdgcn_readfirstlane(tid >> 6), lane = tid & 63, r = lane & 15, q = lane >> 4;
    const int qi = wave * 16 + r;
    const int qic = qi < a.nq ? qi : a.nq - 1;
    const int qpos = a.qpos0 + qic;
    bf16x8 qf[NKS];
#pragma unroll
    for (int ks = 0; ks < NKS; ++ks) qf[ks] = *(const bf16x8*)(a.Q + (size_t)qic * a.ldq + ks * 32 + q * 8);
    f32x4 o[4];
#pragma unroll
    for (int i = 0; i < 4; ++i) o[i] = (f32x4){0.f, 0.f, 0.f, 0.f};
    float m = -1e30f, lsum = 0.f, R = 0.f;
    const float sc = MODE == 1 ? 0.10206207261596575f : 0.125f;
    const int srow8 = lane >> 3;
    const int sf = (((srow8 >> 1) & 1) << 2) | (((srow8 >> 2) & 1) << 1);
    const int schunk = (lane & 7) ^ sf;
    const int kchunk = (lane & 7) ^ (((wave & 1) << 2) | (srow8 >> 1));
    const unsigned wb = (unsigned)wave * 1024u;
#define ASTAGE(ST, KT) { \
        { int key = (KT) * 64 + wave * 8 + srow8; key = key < a.Tk ? key : a.Tk - 1; \
            __builtin_amdgcn_global_load_lds((const unsigned*)(a.K + (size_t)key * a.ldk + kchunk * 8), (LAS unsigned*)(lds + (ST) * ASTG + KOFF + wb), 16, 0, 0); \
            __builtin_amdgcn_global_load_lds((const unsigned*)(a.V + (size_t)key * a.ldv + schunk * 8), (LAS unsigned*)(lds + (ST) * ASTG + VOFF + wb), 16, 0, 0); } \
        if (MODE == 1 && wave < 4) { int key = (KT) * 64 + wave * 16 + (lane >> 2); key = key < a.Tk ? key : a.Tk - 1; \
            __builtin_amdgcn_global_load_lds((const unsigned*)(a.KR + (size_t)key * 32 + ((lane & 3) ^ (((lane >> 5) & 1) << 1)) * 8), (LAS unsigned*)(lds + (ST) * ASTG + KROFF + (unsigned)wave * 1024u), 16, 0, 0); } }
    const int fr_ = (((r >> 1) & 1) << 2) | (((r >> 2) & 1) << 1);
    const unsigned ko0 = (unsigned)(r * 128 + ((q ^ (r >> 1)) << 4)), ko1 = (unsigned)(r * 128 + (((4 + q) ^ (r >> 1)) << 4)), ko2 = (unsigned)(r * 64 + ((q ^ (((r >> 3) & 1) << 1)) << 4));
    const int qq = r >> 2, pp = r & 3;
    const int vf_ = (((qq >> 1) & 1) << 2) | ((q & 1) << 1);
    const unsigned vbase = (unsigned)((q * 4 + qq) * 128 + (pp & 1) * 8);
    __syncthreads();
    {
        const int kt0 = MODE == 0 ? (a.ntiles - 1) : 0;
        ASTAGE(0, kt0);
        if (MODE == 2 && tid < 64) { int key = kt0 * 64 + tid; key = key < a.Tk ? key : a.Tk - 1; *(LAS float*)(lds + FOFF + tid * 4) = a.F[(size_t)key * 4] * LOG2E; }
    }
    for (int it = 0; it < a.ntiles; ++it) {
        const int kt = MODE == 0 ? (a.ntiles - 1 - it) : it;
        const int st_ = it & 1;
        asm volatile("s_waitcnt vmcnt(0)" ::: "memory");
        __syncthreads();
        if (MODE == 0 && it > 0) {
            const LAS unsigned* fl = (const LAS unsigned*)(lds + 2 * ASTG + ((it - 1) & 1) * 64);
            unsigned all = 1u;
#pragma unroll
            for (int w = 0; w < NWAVE; ++w) all &= fl[w];
            if (all) break;
        }
        float fnext = 0.f;
        if (it + 1 < a.ntiles) {
            const int ktn = MODE == 0 ? (kt - 1) : (kt + 1);
            ASTAGE(st_ ^ 1, ktn);
            if (MODE == 2 && tid < 64) { int key = ktn * 64 + tid; key = key < a.Tk ? key : a.Tk - 1; fnext = a.F[(size_t)key * 4] * LOG2E; }
        }
        const LAS char* sK = lds + st_ * ASTG + KOFF;
        const LAS char* sV = lds + st_ * ASTG + VOFF;
        const LAS char* sKR = lds + st_ * ASTG + KROFF;
        const LAS float* sF = (const LAS float*)(lds + st_ * ASTG + FOFF);
        const int qhi = a.qpos0 + min(wave * 16 + 15, a.nq - 1);
        const bool none = (wave * 16 >= a.nq) || (MODE == 0 ? (kt * 64 >= qhi) : MODE == 1 ? (kt > (qhi >> 6)) : (kt * 64 > qhi));
        if (!none) {
        f32x4 s[4];
#pragma unroll
        for (int st = 0; st < 4; ++st) {
            s[st] = (f32x4){0.f, 0.f, 0.f, 0.f};
            s[st] = __builtin_amdgcn_mfma_f32_16x16x32_bf16(*(const LAS bf16x8*)(sK + st * 2048 + ko0), qf[0], s[st], 0, 0, 0);
            s[st] = __builtin_amdgcn_mfma_f32_16x16x32_bf16(*(const LAS bf16x8*)(sK + st * 2048 + ko1), qf[1], s[st], 0, 0, 0);
            if (MODE == 1) s[st] = __builtin_amdgcn_mfma_f32_16x16x32_bf16(*(const LAS bf16x8*)(sKR + st * 1024 + ko2), qf[NKS - 1], s[st], 0, 0, 0);
        }
        float pw[4][4];
        bool full;
        {
            const int qlo = a.qpos0 + min(wave * 16, a.nq - 1), klast = kt * 64 + 63;
            full = MODE == 0 ? (klast < qlo) : (klast < a.Tk && (MODE == 1 ? (kt <= (qlo >> 6)) : (klast <= qlo)));
        }
        if (full) attn_scores<MODE, false>(s, pw, kt, q, qpos, a.Tk, sF, sc, m, lsum, R, o);
        else attn_scores<MODE, true>(s, pw, kt, q, qpos, a.Tk, sF, sc, m, lsum, R, o);
#pragma unroll
        for (int c = 0; c < 2; ++c) {
            u32x4 pk;
            pk.x = pk2(pw[2 * c][0], pw[2 * c][1]); pk.y = pk2(pw[2 * c][2], pw[2 * c][3]);
            pk.z = pk2(pw[2 * c + 1][0], pw[2 * c + 1][1]); pk.w = pk2(pw[2 * c + 1][2], pw[2 * c + 1][3]);
            const bf16x8 pf = __builtin_bit_cast(bf16x8, pk);
#pragma unroll
            for (int dt = 0; dt < 4; ++dt) {
                const unsigned co = (unsigned)(((dt * 2 + (pp >> 1)) ^ vf_) << 4);
                const s16x4 lo = __builtin_amdgcn_ds_read_tr16_b64_v4i16((LAS s16x4*)(sV + (2 * c) * 2048 + vbase + co));
                const s16x4 hi = __builtin_amdgcn_ds_read_tr16_b64_v4i16((LAS s16x4*)(sV + (2 * c + 1) * 2048 + vbase + co));
                const bf16x8 vf = __builtin_shufflevector(lo, hi, 0, 1, 2, 3, 4, 5, 6, 7);
                o[dt] = __builtin_amdgcn_mfma_f32_16x16x32_bf16(vf, pf, o[dt], 0, 0, 0);
            }
        }
        }
        if (MODE == 0) {
            const bool sat = (wave * 16 >= a.nq) || (__builtin_amdgcn_ballot_w64(R < -104.0f) == ~0ull);
            if (lane == 0) *(LAS unsigned*)(lds + 2 * ASTG + (it & 1) * 64 + wave * 4) = sat ? 1u : 0u;
        }
        if (MODE == 2 && tid < 64 && it + 1 < a.ntiles) *(LAS float*)(lds + (st_ ^ 1) * ASTG + FOFF + tid * 4) = fnext;
    }
#undef ASTAGE
    float inv = 1.0f;
    if (MODE != 0) {
        { float a, b; swap16(lsum, a, b); lsum = a + b; swap32(lsum, a, b); lsum = a + b; }
        inv = 1.0f / lsum;
    }
    if (qi < a.nq) {
#pragma unroll
        for (int dt = 0; dt < 4; ++dt) *(f32x4*)(a.O + (size_t)qi * 1024 + dt * 16 + q * 4) = o[dt] * inv;
    }
}

DI void attn_phase(const Params& p, int bid, int nb, char* smem, const int tid) {
    const bf16_t* QA = (const bf16_t*)(p.ws + B_QA); const bf16_t* QC = (const bf16_t*)(p.ws + B_QC); const bf16_t* QB = (const bf16_t*)(p.ws + B_QB);
    const bf16_t* KA = (const bf16_t*)(p.ws + B_KA); const bf16_t* VA = (const bf16_t*)(p.ws + B_VA);
    const bf16_t* KC = (const bf16_t*)(p.ws + B_KC); const bf16_t* VC = (const bf16_t*)(p.ws + B_VC);
    const bf16_t* KVB = (const bf16_t*)(p.ws + B_KVB); const bf16_t* KR = (const bf16_t*)(p.ws + B_KR);
    const float* Fall = (const float*)(p.ws + B_F);
    float* O = (float*)(p.ws + B_Y);
    const bool xmap = nb == 256;
    const int nrounds = xmap ? 9 : (128 + 2048 + nb - 1) / nb;
    for (int rnd = 0; rnd < nrounds; ++rnd) {
        int b, hs, qrow0, krow0, nq, qpos0, Tk, nt;
        if (xmap) {
            if (rnd < 8) {
                const int i = bid >> 3;
                int qb;
                if (rnd < 2) {
                    const int pi = i & 3;
                    hs = (i >> 2) & 3;
                    qb = i < 16 ? (rnd == 0 ? pi : 11 - pi) : (rnd == 0 ? 15 - pi : 4 + pi);
                } else {
                    const int L = ((i & 15) + 4 * (rnd >> 1)) & 15;
                    qb = (rnd & 1) ? 15 - L : L;
                    hs = 2 * rnd + (i >> 4);
                }
                b = bid & 7;
                qrow0 = b * SEQ + qb * 128; krow0 = b * SEQ; nq = 128; qpos0 = qb * 128; Tk = SEQ; nt = 2 * qb + 2;
            } else {
                if (bid >= 128) continue;
                b = bid >> 4; hs = bid & 15; qrow0 = NP + b * TS; krow0 = NP + b * TKS; nq = TS; qpos0 = PAST; Tk = TKS; nt = 17;
            }
        } else {
            const int k = rnd * nb + ((rnd & 1) ? (nb - 1 - bid) : bid);
            if (k >= 128 + 2048) continue;
            if (k >= 1024 && k < 1152) { const int it = k - 1024; b = it >> 4; hs = it & 15; qrow0 = NP + b * TS; krow0 = NP + b * TKS; nq = TS; qpos0 = PAST; Tk = TKS; nt = 17; }
            else { const int j = k < 1024 ? k : k - 128; const int qb = 15 - (j >> 7); b = (j >> 4) & 7; hs = ((j & 15) + 5 * (j >> 7)) & 15; qrow0 = b * SEQ + qb * 128; krow0 = b * SEQ; nq = 128; qpos0 = qb * 128; Tk = SEQ; nt = 2 * qb + 2; }
        }
        AttnItem a;
        a.nq = nq; a.qpos0 = qpos0; a.Tk = Tk; a.ntiles = nt; a.KR = nullptr; a.F = nullptr;
        if (hs < 8) {
            a.Q = QB + (size_t)qrow0 * 768 + hs * 96; a.ldq = 768;
            a.K = KVB + (size_t)krow0 * 1024 + hs * 128; a.ldk = 1024; a.KR = KR + (size_t)krow0 * 32;
            a.V = KVB + (size_t)krow0 * 1024 + hs * 128 + 64; a.ldv = 1024;
            a.O = O + (size_t)qrow0 * 1024 + 256 + hs * 64;
            attn_item<1>(a, smem, tid);
        } else if (hs < 12) {
            const int h = hs - 8;
            a.Q = QA + (size_t)qrow0 * 256 + h * 64; a.ldq = 256;
            a.K = KA + (size_t)krow0 * 256 + h * 64; a.ldk = 256;
            a.V = VA + (size_t)krow0 * 256 + h * 64; a.ldv = 256;
            a.O = O + (size_t)qrow0 * 1024 + h * 64;
            attn_item<0>(a, smem, tid);
        } else {
            const int h = hs - 12;
            a.Q = QC + (size_t)qrow0 * 256 + h * 64; a.ldq = 256;
            a.K = KC + (size_t)krow0 * 256 + h * 64; a.ldk = 256;
            a.V = VC + (size_t)krow0 * 256 + h * 64; a.ldv = 256;
            a.F = Fall + (size_t)krow0 * 4 + h;
            a.O = O + (size_t)qrow0 * 1024 + 768 + h * 64;
            attn_item<2>(a, smem, tid);
        }
    }
}


#define XB_TMO      128
#define XB_XCNT(j)  (256  + 64 * (j))
#define XB_XSUB(j)  (1280 + 64 * (j))
#define XB_XGEN(j)  (2304 + 64 * (j))
#define XB_TOP      3328
#define XB_TOPGEN   3392
#define XCD_BAR_WORDS 3456
#define XB_SPIN_CAP (1u << 22)
DI unsigned xb_ld(unsigned* p) { return __hip_atomic_load(p, __ATOMIC_RELAXED, __HIP_MEMORY_SCOPE_AGENT); }
DI unsigned xb_add(unsigned* p, unsigned v) { return __hip_atomic_fetch_add(p, v, __ATOMIC_RELAXED, __HIP_MEMORY_SCOPE_AGENT); }
DI unsigned xb_xcc_id() { return (unsigned)__builtin_amdgcn_s_getreg((3 << 11) | 20) & 0xFu; }
#define XB_SPIN(cond, bar) do { unsigned _sp = 0; while (cond) { __builtin_amdgcn_s_sleep(1); \
    if ((++_sp & 255u) == 0u) { if (xb_ld(&(bar)[XB_TMO])) break; if (_sp > XB_SPIN_CAP) { atomicAdd(&(bar)[XB_TMO], 1u); break; } } } } while (0)
struct XcdBarrier { unsigned* bar; unsigned x; volatile LAS unsigned* st; };
DI XcdBarrier xcd_barrier_post(unsigned* bar, volatile LAS unsigned* st) {
    XcdBarrier b; b.bar = bar; b.x = xb_xcc_id(); b.st = st;
    if (threadIdx.x == 0) (void)xb_add(&bar[XB_XCNT(b.x)], 1u);
    return b;
}
DI void xcd_barrier_complete(unsigned* bar, unsigned x, unsigned& nloc, unsigned& nx) {
    const unsigned G = gridDim.x * gridDim.y * gridDim.z;
    unsigned sum, cnt, mine, sp = 0u;
    for (;;) {
        sum = 0u; cnt = 0u; mine = 0u;
#pragma unroll
        for (unsigned j = 0; j < 16; ++j) { const unsigned c = xb_ld(&bar[XB_XCNT(j)]); sum += c; cnt += (c > 0u) ? 1u : 0u; mine = (j == x) ? c : mine; }
        if (sum == G) break;
        __builtin_amdgcn_s_sleep(1);
        if ((++sp & 255u) == 0u) { if (xb_ld(&bar[XB_TMO])) break; if (sp > XB_SPIN_CAP) { atomicAdd(&bar[XB_TMO], 1u); break; } }
    }
    nloc = mine > 0u ? mine : 1u; nx = cnt > 0u ? cnt : 1u;
}
DI void xcd_barrier(const XcdBarrier& b) {
    asm volatile("s_waitcnt vmcnt(0)" ::: "memory");
    __syncthreads();
    if (threadIdx.x == 0) {
        unsigned* bar = b.bar;
        __builtin_amdgcn_s_waitcnt(0);
        unsigned nloc = b.st[0], nx = b.st[1];
        if (nloc == 0u) { xcd_barrier_complete(bar, b.x, nloc, nx); b.st[0] = nloc; b.st[1] = nx; }
        const unsigned old = xb_add(&bar[XB_XSUB(b.x)], 1u);
        const unsigned gen = old / nloc;
        if (old + 1u == (gen + 1u) * nloc) {
            __builtin_amdgcn_fence(__ATOMIC_RELEASE, "agent");
            asm volatile("s_waitcnt vmcnt(0)" ::: "memory");
            const unsigned og = xb_add(&bar[XB_TOP], 1u);
            const unsigned tg = og / nx;
            if (og + 1u == (tg + 1u) * nx) xb_add(&bar[XB_TOPGEN], 1u);
            else XB_SPIN(xb_ld(&bar[XB_TOPGEN]) == tg, bar);
            __builtin_amdgcn_fence(__ATOMIC_ACQUIRE, "agent");
            xb_add(&bar[XB_XGEN(b.x)], 1u);
            asm volatile("s_waitcnt vmcnt(0)" ::: "memory");
        } else {
            XB_SPIN(xb_ld(&bar[XB_XGEN(b.x)]) == gen, bar);
            __builtin_amdgcn_fence(__ATOMIC_ACQUIRE, "agent");
            asm volatile("s_waitcnt vmcnt(0)" ::: "memory");
        }
    }
    __syncthreads();
}

constexpr int NPHASE = 31;
DI void run_phase(const Params& pk, int ph, int bid_, int nb, char* smem) {
    int tid = threadIdx.x; asm volatile("" : "+v"(tid));
    int bid = bid_; asm volatile("" : "+s"(bid));
    Params p = pk;
    asm volatile("" : "+s"(p.ws));
    asm volatile("" : "+s"(p.out));
    if (ph == 0) {
        prep_phase(p, 0, bid, nb, smem, tid);
        rowpass(p, true, 0.f, nullptr, p.in[11], 1, bid, nb, tid);
        return;
    }
    const int l = (ph - 1) / 15, s = (ph - 1) % 15;
    switch (s) {
    case 0: gemm_gu(p, W_GU1, bid, nb, smem, tid); break;
    case 1: gemm_y(p, (const bf16_t*)(p.ws + B_ACT), DFF, W_DN1, DFF, 4, bid, nb, smem, tid); break;
    case 2: rowpass(p, false, 0.5f, p.in[12] + l * DM, p.in[15] + l * DM, 11, bid, nb, tid); break;
    case 3: gemm_in(p, l, bid, nb, smem, tid); break;
    case 4: post_phase(p, l, bid, nb, tid); break;
    case 5: gemm_uqkv(p, bid, nb, smem, tid); break;
    case 6: attn_phase(p, bid, nb, smem, tid); break;
    case 7: onorm_pass(p, p.in[23] + l * DM, bid, nb, tid); break;
    case 8: gemm_y(p, (const bf16_t*)(p.ws + B_XN), DM, W_OUT, DM, 2, bid, nb, smem, tid); break;
    case 9: rowpass(p, false, 1.0f, p.in[16] + l * DM, p.in[25] + l * DM, 8, bid, nb, tid); break;
    case 10: gemm_gu(p, W_GU2, bid, nb, smem, tid); break;
    case 11: gemm_y(p, (const bf16_t*)(p.ws + B_ACT), DFF, W_DN2, DFF, 4, bid, nb, smem, tid); break;
    case 12: rowpass(p, false, 0.5f, p.in[26] + l * DM, p.in[29] + l * DM, 11, bid, nb, tid); break;
    case 13: gemm_ple(p, bid, nb, smem, tid); break;
    case 14:
        rowpass(p, false, 1.0f, p.in[32] + l * DM, l == 0 ? p.in[11] + DM : nullptr, 1, bid, nb, tid);
        if (l == 0) prep_phase(p, 1, bid, nb, smem, tid);
        break;
    }
}

extern "C" __global__ void __launch_bounds__(512, 2) fwd_kernel(Params p, int ph0, int ph1) {
    extern __shared__ __attribute__((aligned(16))) char smem[];
#if MEGA
    __shared__ uint4 xb_words;
    if (threadIdx.x == 0) xb_words = make_uint4(0u, 0u, 0u, 0u);
    __syncthreads();
    XcdBarrier xb = xcd_barrier_post((unsigned*)(p.ws + B_BAR), (volatile LAS unsigned*)&xb_words);
    if (ph1 > 100000) cg::this_grid().sync();
#ifdef PROBE_DUP
    for (int pp = 2 * ph0; pp < 2 * ph1; ++pp) {
        const int ph = pp >> 1;
        if ((pp & 1) && !((ph > 0 && ((PROBE_DUP >> ((ph - 1) % 15)) & 1)) || (ph == 0 && (PROBE_DUP >> 20)))) continue;
        run_phase(p, ph, blockIdx.x, gridDim.x, smem);
        xcd_barrier(xb);
    }
#else
    for (int ph = ph0; ph < ph1; ++ph) {
        run_phase(p, ph, blockIdx.x, gridDim.x, smem);
        if (ph + 1 < ph1) xcd_barrier(xb);
    }
#endif
#else
    for (int ph = ph0; ph < ph1; ++ph) run_phase(p, ph, blockIdx.x, gridDim.x, smem);
#endif
}

extern "C" void kernel_launch(void* const* d_in, const int* in_sizes, int n_in, void* d_out, int out_size, void* d_ws, size_t ws_size, hipStream_t stream) {
    static int grid_blocks = 0;
    if (!grid_blocks) {
        int dev = 0, cus = 0, per_cu = 0;
        hipGetDevice(&dev);
        hipDeviceGetAttribute(&cus, hipDeviceAttributeMultiprocessorCount, dev);
        hipFuncSetAttribute((const void*)fwd_kernel, hipFuncAttributeMaxDynamicSharedMemorySize, LDS_BYTES);
        hipOccupancyMaxActiveBlocksPerMultiprocessor(&per_cu, fwd_kernel, NTHR, LDS_BYTES);
        if (per_cu < 1) per_cu = 1;
        if (per_cu > 1) per_cu = 1;
        grid_blocks = cus * per_cu;
    }
    if (ws_size < WS_TOTAL) { fprintf(stderr, "workspace too small: %zu < %zu\n", ws_size, (size_t)WS_TOTAL); return; }
    Params p{};
    for (int i = 0; i < 33; ++i) p.in[i] = (const float*)d_in[i];
    p.out = (float*)d_out;
    p.ws = (char*)d_ws;
#if MEGA
    hipMemsetAsync((char*)d_ws + B_BAR, 0, XCD_BAR_WORDS * 4, stream);
    int ph0 = 0, ph1 = NPHASE;
    void* args[] = {&p, &ph0, &ph1};
    hipError_t e = hipLaunchCooperativeKernel((const void*)fwd_kernel, dim3(grid_blocks), dim3(NTHR), args, LDS_BYTES, stream);
    if (e != hipSuccess) fprintf(stderr, "cooperative launch failed: %s (grid %d)\n", hipGetErrorString(e), grid_blocks);
#else
    for (int ph = 0; ph < NPHASE; ++ph) hipLaunchKernelGGL(fwd_kernel, dim3(grid_blocks), dim3(NTHR), LDS_BYTES, stream, p, ph, ph + 1);
#endif
}
```

```cpp
#include <hip/hip_runtime.h>
#include <hip/hip_cooperative_groups.h>
#include <cstdio>
#include <cstdint>
namespace cg = cooperative_groups;

#ifndef MEGA
#define MEGA 1
#endif

typedef unsigned short bf16_t;
typedef short bf16x8 __attribute__((ext_vector_type(8)));
typedef short s16x4 __attribute__((ext_vector_type(4)));
typedef float f32x4 __attribute__((ext_vector_type(4)));
typedef unsigned u32x4 __attribute__((ext_vector_type(4)));
typedef unsigned u32x2 __attribute__((ext_vector_type(2)));

#define DI __device__ __forceinline__
#define LAS __attribute__((address_space(3)))

constexpr int DM = 1024, NP = 16384, NS = 256, MT = NP + NS;
constexpr int SEQ = 2048, TS = 32, PAST = 1024, TKS = PAST + TS;
constexpr int KALL = NP + 8 * TKS;
constexpr int DFF = 2816;
constexpr float EPS = 1e-6f;
constexpr float LOG2E = 1.4426950408889634f;

constexpr size_t O_Y = 0;
constexpr size_t O_AKP = (size_t)MT * 1024;
constexpr size_t O_AVP = O_AKP + 8388608;
constexpr size_t O_BCKVP = O_AVP + 8388608;
constexpr size_t O_BKRP = O_BCKVP + 4194304;
constexpr size_t O_CKP = O_BKRP + 1048576;
constexpr size_t O_CVP = O_CKP + 8388608;
constexpr size_t O_CLFP = O_CVP + 8388608;
constexpr size_t O_AKS = O_CLFP + 131072;
constexpr size_t O_AVS = O_AKS + 131072;
constexpr size_t O_BCKVS = O_AVS + 131072;
constexpr size_t O_BKRS = O_BCKVS + 65536;
constexpr size_t O_CKS = O_BKRS + 16384;
constexpr size_t O_CVS = O_CKS + 131072;
constexpr size_t O_CLFS = O_CVS + 131072;

constexpr size_t al256(size_t x) { return (x + 255) & ~(size_t)255; }
constexpr size_t W_GU1 = 0;
constexpr size_t W_DN1 = W_GU1 + (size_t)5632 * 1024 * 2;
constexpr size_t W_IN = W_DN1 + (size_t)1024 * 2816 * 2;
constexpr size_t W_UQ = W_IN + (size_t)2048 * 1024 * 2;
constexpr size_t W_UKV = W_UQ + (size_t)768 * 256 * 2;
constexpr size_t W_OUT = W_UKV + (size_t)1024 * 128 * 2;
constexpr size_t W_GU2 = W_OUT + (size_t)1024 * 1024 * 2;
constexpr size_t W_DN2 = W_GU2 + (size_t)5632 * 1024 * 2;
constexpr size_t W_PG = W_DN2 + (size_t)1024 * 2816 * 2;
constexpr size_t W_PP = W_PG + (size_t)1024 * 1024 * 2;
constexpr size_t W_PBF = W_PP + (size_t)1024 * 256 * 2;
constexpr size_t W_END = W_PBF + (size_t)MT * 256 * 2;
constexpr size_t B_XN = al256(W_END);
constexpr size_t B_ACT = B_XN + (size_t)MT * 1024 * 2;
constexpr size_t B_Y = B_ACT + (size_t)MT * 2816 * 2;
constexpr size_t B_X1 = B_Y + (size_t)MT * 1024 * 4;
constexpr size_t B_QA = B_ACT;
constexpr size_t B_QC = B_QA + (size_t)MT * 256 * 2;
constexpr size_t B_QB = B_QC + (size_t)MT * 256 * 2;
constexpr size_t B_KA = B_QB + (size_t)MT * 768 * 2;
constexpr size_t B_VA = B_KA + (size_t)KALL * 256 * 2;
constexpr size_t B_KC = B_VA + (size_t)KALL * 256 * 2;
constexpr size_t B_VC = B_KC + (size_t)KALL * 256 * 2;
constexpr size_t B_ACT_END = B_VC + (size_t)KALL * 256 * 2;
static_assert(B_ACT_END <= B_Y, "mixer overlay exceeds act region");
constexpr size_t B_SMALL = B_Y;
constexpr size_t B_CQN = B_SMALL + (size_t)MT * 512 * 4;
static_assert(B_CQN + (size_t)MT * 256 * 2 <= B_X1, "Y overlay");
constexpr size_t B_CKVN = B_X1;
constexpr size_t B_KR = B_CKVN + (size_t)KALL * 128 * 2;
constexpr size_t B_F = B_KR + (size_t)KALL * 32 * 2;
constexpr size_t B_KVB = al256(B_F + (size_t)KALL * 4 * 4);
constexpr size_t B_YS = al256(B_KVB + (size_t)KALL * 1024 * 2);
constexpr size_t B_BAR = al256(B_YS + (size_t)11 * NS * 1024 * 4);
constexpr size_t WS_TOTAL = B_BAR + 3456 * 4;

constexpr int LDS_BYTES = 147456;
constexpr int NTHR = 512, NWAVE = 8;

struct Params {
    const float* in[33];
    float* out;
    char* ws;
};

typedef __bf16 bf2_t __attribute__((ext_vector_type(2)));
typedef float f32x2 __attribute__((ext_vector_type(2)));
DI unsigned pk2(float lo, float hi) { const f32x2 v = {lo, hi}; return __builtin_bit_cast(unsigned, __builtin_convertvector(v, bf2_t)); }
DI bf16_t f2bf(float x) { return (bf16_t)(pk2(x, 0.f) & 0xffffu); }
DI float wave_sum(float v) {
#pragma unroll
    for (int o = 32; o >= 1; o >>= 1) v += __shfl_xor(v, o);
    return v;
}
DI void swap16(float x, float& a, float& b) { const auto r = __builtin_amdgcn_permlane16_swap(__float_as_uint(x), __float_as_uint(x), false, false); a = __uint_as_float(r[0]); b = __uint_as_float(r[1]); }
DI void swap32(float x, float& a, float& b) { const auto r = __builtin_amdgcn_permlane32_swap(__float_as_uint(x), __float_as_uint(x), false, false); a = __uint_as_float(r[0]); b = __uint_as_float(r[1]); }
DI float log_sigmoid_f(float x) { return fminf(x, 0.f) - log1pf(expf(-fabsf(x))); }
DI void rope_cs(int pos, int i, float& c, float& s) {
    float inv = exp2f(-(float)i * (13.287712379549449f / 16.0f));
    float rev = (float)pos * inv * 0.15915494309189535f;
    rev -= rintf(rev);
    c = __builtin_amdgcn_cosf(rev);
    s = __builtin_amdgcn_sinf(rev);
}
DI int krow_of(int r) { return r < NP ? r : NP + ((r - NP) >> 5) * TKS + PAST + ((r - NP) & 31); }

DI int wmap(int mode, int n) {
    if (mode == 1) { return n < DFF ? ((n >> 4) * 32 + (n & 15)) : (((n - DFF) >> 4) * 32 + 16 + ((n - DFF) & 15)); }
    if (mode == 2) {
        if (n < 768) return n;
        if (n < 1024) return 1536 + (n - 768);
        if (n < 1152) return 1792 + (n - 1024);
        if (n < 1184) return 1920 + (n - 1152);
        if (n < 1952) return 768 + (n - 1184);
        return n;
    }
    return n;
}

DI void wtile(const float* __restrict__ src, bf16_t* __restrict__ dst, int K, int Nsrc, int mode, int tk, int tn, float* tile, const int tid) {
    const int wave = tid >> 6, lane = tid & 63;
    __syncthreads();
    float4 v[8];
    const int n4 = tn * 256 + lane * 4;
#pragma unroll
    for (int i = 0; i < 8; ++i) {
        const int k = tk * 64 + wave * 8 + i;
        v[i] = make_float4(0.f, 0.f, 0.f, 0.f);
        if (n4 < Nsrc) v[i] = *(const float4*)(src + (size_t)k * Nsrc + n4);
    }
#pragma unroll
    for (int i = 0; i < 8; ++i) *(float4*)(tile + (wave * 8 + i) * 260 + lane * 4) = v[i];
    __syncthreads();
    const int nl = tid & 255, n = tn * 256 + nl;
    if (n < Nsrc) {
        const int dr = wmap(mode, n);
#pragma unroll
        for (int i = 0; i < 4; ++i) {
            const int kc = ((tid >> 8) + 2 * i) * 8;
            const float* t = tile + kc * 260 + nl;
            u32x4 w;
            w.x = pk2(t[0], t[260]); w.y = pk2(t[2 * 260], t[3 * 260]); w.z = pk2(t[4 * 260], t[5 * 260]); w.w = pk2(t[6 * 260], t[7 * 260]);
            *(u32x4*)(dst + (size_t)dr * K + tk * 64 + kc) = w;
        }
    }
}

DI void prep_phase(const Params& p, int l, int bid, int nb, char* smem, const int tid) {
    float* tile = (float*)smem;
    for (int t = bid; t < 1348; t += nb) {
        const float* src; bf16_t* dst; int K, N, mode, base;
        if (t < 352) { src = p.in[13] + (size_t)l * 1024 * 5632; dst = (bf16_t*)(p.ws + W_GU1); K = 1024; N = 5632; mode = 1; base = 0; }
        else if (t < 528) { src = p.in[14] + (size_t)l * 2816 * 1024; dst = (bf16_t*)(p.ws + W_DN1); K = 2816; N = 1024; mode = 0; base = 352; }
        else if (t < 656) { src = p.in[17] + (size_t)l * 1024 * 1956; dst = (bf16_t*)(p.ws + W_IN); K = 1024; N = 1956; mode = 2; base = 528; }
        else if (t < 668) { src = p.in[21] + (size_t)l * 256 * 768; dst = (bf16_t*)(p.ws + W_UQ); K = 256; N = 768; mode = 0; base = 656; }
        else if (t < 676) { src = p.in[22] + (size_t)l * 128 * 1024; dst = (bf16_t*)(p.ws + W_UKV); K = 128; N = 1024; mode = 0; base = 668; }
        else if (t < 740) { src = p.in[24] + (size_t)l * 1024 * 1024; dst = (bf16_t*)(p.ws + W_OUT); K = 1024; N = 1024; mode = 0; base = 676; }
        else if (t < 1092) { src = p.in[27] + (size_t)l * 1024 * 5632; dst = (bf16_t*)(p.ws + W_GU2); K = 1024; N = 5632; mode = 1; base = 740; }
        else if (t < 1268) { src = p.in[28] + (size_t)l * 2816 * 1024; dst = (bf16_t*)(p.ws + W_DN2); K = 2816; N = 1024; mode = 0; base = 1092; }
        else if (t < 1332) { src = p.in[30] + (size_t)l * 1024 * 1024; dst = (bf16_t*)(p.ws + W_PG); K = 1024; N = 1024; mode = 0; base = 1268; }
        else { src = p.in[31] + (size_t)l * 256 * 1024; dst = (bf16_t*)(p.ws + W_PP); K = 256; N = 1024; mode = 0; base = 1332; }
        const int lt = t - base, nkt = K / 64;
        wtile(src, dst, K, N, mode, lt % nkt, lt / nkt, tile, tid);
    }
    {
        bf16_t* win = (bf16_t*)(p.ws + W_IN);
        const int total = (2048 - 1956) * 1024 / 8;
        for (int i = bid * NTHR + tid; i < total; i += nb * NTHR) {
            u32x4 z = {0u, 0u, 0u, 0u};
            *(u32x4*)(win + (size_t)1956 * 1024 + (size_t)i * 8) = z;
        }
    }
    {
        bf16_t* pbf = (bf16_t*)(p.ws + W_PBF);
        const int total = MT * 256 / 8;
        for (int i = bid * NTHR + tid; i < total; i += nb * NTHR) {
            const size_t e = (size_t)i * 8;
            const float* s = (e < (size_t)NP * 256) ? (p.in[2] + (size_t)l * NP * 256 + e) : (p.in[3] + (size_t)l * NS * 256 + (e - (size_t)NP * 256));
            const float4 a = *(const float4*)s, b = *(const float4*)(s + 4);
            u32x4 w; w.x = pk2(a.x, a.y); w.y = pk2(a.z, a.w); w.z = pk2(b.x, b.y); w.w = pk2(b.z, b.w);
            *(u32x4*)(pbf + e) = w;
        }
    }
}

DI void rowpass(const Params& p, bool init, float scale, const float* __restrict__ gpost, const float* __restrict__ gnext, int nparts, int bid, int nb, const int tid) {
    const int wave = __builtin_amdgcn_readfirstlane(tid >> 6), lane = tid & 63;
    float* H = p.out + O_Y;
    const bf16_t* YB = (const bf16_t*)(p.ws + B_Y);
    const float* YS = (const float*)(p.ws + B_YS);
    bf16_t* XN = (bf16_t*)(p.ws + B_XN);
    for (int row = bid * NWAVE + wave; row < MT; row += nb * NWAVE) {
        float4 h[4];
        if (init) {
            const float* x = row < NP ? p.in[0] + (size_t)row * DM : p.in[1] + (size_t)(row - NP) * DM;
#pragma unroll
            for (int i = 0; i < 4; ++i) h[i] = *(const float4*)(x + i * 256 + lane * 4);

        } else {
            float4 y[4];
            float ss = 0.f;
#pragma unroll
            for (int i = 0; i < 4; ++i) h[i] = *(const float4*)(H + (size_t)row * DM + i * 256 + lane * 4);
            if (row < NP) {
                u32x2 yb[4];
#pragma unroll
                for (int i = 0; i < 4; ++i) yb[i] = *(const u32x2*)(YB + (size_t)row * DM + i * 256 + lane * 4);
#pragma unroll
                for (int i = 0; i < 4; ++i) y[i] = make_float4(__uint_as_float(yb[i].x << 16), __uint_as_float(yb[i].x & 0xffff0000u), __uint_as_float(yb[i].y << 16), __uint_as_float(yb[i].y & 0xffff0000u));
            } else {
#pragma unroll
                for (int i = 0; i < 4; ++i) y[i] = make_float4(0.f, 0.f, 0.f, 0.f);
                for (int pt = 0; pt < nparts; ++pt) {
#pragma unroll
                    for (int i = 0; i < 4; ++i) { const float4 u = *(const float4*)(YS + (size_t)pt * NS * DM + (size_t)(row - NP) * DM + i * 256 + lane * 4); y[i].x += u.x; y[i].y += u.y; y[i].z += u.z; y[i].w += u.w; }
                }
            }
#pragma unroll
            for (int i = 0; i < 4; ++i) ss += y[i].x * y[i].x + y[i].y * y[i].y + y[i].z * y[i].z + y[i].w * y[i].w;
            ss = wave_sum(ss);
            const float rs = rsqrtf(ss * (1.0f / DM) + EPS) * scale;
#pragma unroll
            for (int i = 0; i < 4; ++i) {
                const float4 g = *(const float4*)(gpost + i * 256 + lane * 4);
                h[i].x += y[i].x * rs * g.x; h[i].y += y[i].y * rs * g.y; h[i].z += y[i].z * rs * g.z; h[i].w += y[i].w * rs * g.w;
            }
        }
#pragma unroll
        for (int i = 0; i < 4; ++i) *(float4*)(H + (size_t)row * DM + i * 256 + lane * 4) = h[i];
        if (gnext) {
            float s2 = 0.f;
#pragma unroll
            for (int i = 0; i < 4; ++i) s2 += h[i].x * h[i].x + h[i].y * h[i].y + h[i].z * h[i].z + h[i].w * h[i].w;
            s2 = wave_sum(s2);
            const float r2 = rsqrtf(s2 * (1.0f / DM) + EPS);
#pragma unroll
            for (int i = 0; i < 4; ++i) {
                const float4 g = *(const float4*)(gnext + i * 256 + lane * 4);
                u32x2 w; w.x = pk2(h[i].x * r2 * g.x, h[i].y * r2 * g.y); w.y = pk2(h[i].z * r2 * g.z, h[i].w * r2 * g.w);
                *(u32x2*)(XN + (size_t)row * DM + i * 256 + lane * 4) = w;
            }
        }
    }
}

DI void onorm_pass(const Params& p, const float* __restrict__ ggrp, int bid, int nb, const int tid) {
    const int wave = __builtin_amdgcn_readfirstlane(tid >> 6), lane = tid & 63;
    const float* Y = (const float*)(p.ws + B_Y);
    bf16_t* XN = (bf16_t*)(p.ws + B_XN);
    for (int row = bid * NWAVE + wave; row < MT; row += nb * NWAVE) {
        float4 y[4]; float ss[4];
#pragma unroll
        for (int i = 0; i < 4; ++i) {
            y[i] = *(const float4*)(Y + (size_t)row * DM + i * 256 + lane * 4);
            ss[i] = wave_sum(y[i].x * y[i].x + y[i].y * y[i].y + y[i].z * y[i].z + y[i].w * y[i].w);
        }
        const float ra = rsqrtf(ss[0] * (1.0f / 256) + EPS), rb = rsqrtf((ss[1] + ss[2]) * (1.0f / 512) + EPS), rc = rsqrtf(ss[3] * (1.0f / 256) + EPS);
#pragma unroll
        for (int i = 0; i < 4; ++i) {
            const float r = i == 0 ? ra : (i == 3 ? rc : rb);
            const float4 g = *(const float4*)(ggrp + i * 256 + lane * 4);
            u32x2 w; w.x = pk2(y[i].x * r * g.x, y[i].y * r * g.y); w.y = pk2(y[i].z * r * g.z, y[i].w * r * g.w);
            *(u32x2*)(XN + (size_t)row * DM + i * 256 + lane * 4) = w;
        }
    }
}

DI void post_phase(const Params& p, int l, int bid, int nb, const int tid) {
    const int wave = __builtin_amdgcn_readfirstlane(tid >> 6), lane = tid & 63;
    const int gw = bid * NWAVE + wave, nw = nb * NWAVE;
    const float* SM = (const float*)(p.ws + B_SMALL);
    const float* bf_ = p.in[18] + l * 4;
    float* Fall = (float*)(p.ws + B_F);
    for (int sq = (wave == 0 ? bid : 64); sq < 64; sq += nb) {
        const int h = sq & 3, b = (sq >> 2) & 7;
        const float bfh = bf_[h];
        if (sq < 32) {
            float v[32]; float run = 0.f;
#pragma unroll
            for (int j = 0; j < 32; ++j) {
                const int e = lane * 32 + j;
                v[j] = log_sigmoid_f(SM[(size_t)(b * SEQ + e) * 512 + 416 + h] + bfh);
            }
#pragma unroll
            for (int j = 0; j < 32; ++j) { run += v[j]; v[j] = run; }
            float inc = run;
#pragma unroll
            for (int o = 1; o < 64; o <<= 1) { float t = __shfl_up(inc, o); if (lane >= o) inc += t; }
            const float ex = inc - run;
#pragma unroll
            for (int j = 0; j < 32; ++j) Fall[(size_t)(b * SEQ + lane * 32 + j) * 4 + h] = v[j] + ex;
        } else {
            const float* clf = p.in[10] + (size_t)(l * 8 + b) * PAST * 4;
            float v[17]; float run = 0.f;
#pragma unroll
            for (int j = 0; j < 17; ++j) {
                const int e = lane * 17 + j;
                float x = 0.f;
                if (e < PAST) x = clf[e * 4 + h];
                else if (e < TKS) x = log_sigmoid_f(SM[(size_t)(NP + b * TS + (e - PAST)) * 512 + 416 + h] + bfh);
                v[j] = x;
            }
#pragma unroll
            for (int j = 0; j < 17; ++j) { run += v[j]; v[j] = run; }
            float inc = run;
#pragma unroll
            for (int o = 1; o < 64; o <<= 1) { float t = __shfl_up(inc, o); if (lane >= o) inc += t; }
            const float ex = inc - run;
#pragma unroll
            for (int j = 0; j < 17; ++j) { const int e = lane * 17 + j; if (e < TKS) Fall[(size_t)(NP + b * TKS + e) * 4 + h] = v[j] + ex; }
        }
    }
    bf16_t* CQN = (bf16_t*)(p.ws + B_CQN);
    bf16_t* CKVN = (bf16_t*)(p.ws + B_CKVN);
    bf16_t* KR = (bf16_t*)(p.ws + B_KR);
    const float* gbq = p.in[19] + l * 256;
    const float* gbkv = p.in[20] + l * 128;
    for (int r = gw; r < MT; r += nw) {
        const float* s = SM + (size_t)r * 512;
        const int kr = krow_of(r);
        const bool samp = r >= NP;
        const size_t srow = samp ? (size_t)(l * NS + (r - NP)) : (size_t)(l * NP + r);
        {
            const float4 v = *(const float4*)(s + lane * 4);
            const float ss = wave_sum(v.x * v.x + v.y * v.y + v.z * v.z + v.w * v.w);
            const float rs = rsqrtf(ss * (1.0f / 256) + EPS);
            const float4 g = *(const float4*)(gbq + lane * 4);
            u32x2 w; w.x = pk2(v.x * rs * g.x, v.y * rs * g.y); w.y = pk2(v.z * rs * g.z, v.w * rs * g.w);
            *(u32x2*)(CQN + (size_t)r * 256 + lane * 4) = w;
        }
        {
            const float2 v = *(const float2*)(s + 256 + lane * 2);
            const float ss = wave_sum(v.x * v.x + v.y * v.y);
            const float rs = rsqrtf(ss * (1.0f / 128) + EPS);
            const float2 g = *(const float2*)(gbkv + lane * 2);
            const float a = v.x * rs * g.x, b = v.y * rs * g.y;
            float* so = p.out + (samp ? O_BCKVS : O_BCKVP) + srow * 128 + lane * 2;
            *(float2*)so = make_float2(a, b);
            *(unsigned*)(CKVN + (size_t)kr * 128 + lane * 2) = pk2(a, b);
        }
        if (lane < 16) {
            const float x1 = s[384 + lane], x2 = s[400 + lane];
            const int pos = samp ? PAST + ((r - NP) & 31) : (r & (SEQ - 1));
            float c, sn; rope_cs(pos, lane, c, sn);
            const float o1 = x1 * c - x2 * sn, o2 = x1 * sn + x2 * c;
            float* so = p.out + (samp ? O_BKRS : O_BKRP) + srow * 32;
            so[lane] = o1; so[lane + 16] = o2;
            KR[(size_t)kr * 32 + lane] = f2bf(o1); KR[(size_t)kr * 32 + 16 + lane] = f2bf(o2);
        }
        if (lane < 4) {
            const float lf = log_sigmoid_f(s[416 + lane] + bf_[lane]);
            p.out[(samp ? O_CLFS : O_CLFP) + srow * 4 + lane] = lf;
        }
    }
    bf16_t* KA = (bf16_t*)(p.ws + B_KA); bf16_t* VA = (bf16_t*)(p.ws + B_VA);
    bf16_t* KC = (bf16_t*)(p.ws + B_KC); bf16_t* VC = (bf16_t*)(p.ws + B_VC);
    for (int cr = gw; cr < 8 * PAST; cr += nw) {
        const int b = cr >> 10, t = cr & (PAST - 1);
        const size_t crow = (size_t)(l * 8 + b) * PAST + t;
        const size_t kr = (size_t)NP + b * TKS + t;
        {
            const float4 a = *(const float4*)(p.in[4] + crow * 256 + lane * 4);
            u32x2 w; w.x = pk2(a.x, a.y); w.y = pk2(a.z, a.w); *(u32x2*)(KA + kr * 256 + lane * 4) = w;
            const float4 b4 = *(const float4*)(p.in[5] + crow * 256 + lane * 4);
            w.x = pk2(b4.x, b4.y); w.y = pk2(b4.z, b4.w); *(u32x2*)(VA + kr * 256 + lane * 4) = w;
            const float4 c4 = *(const float4*)(p.in[8] + crow * 256 + lane * 4);
            w.x = pk2(c4.x, c4.y); w.y = pk2(c4.z, c4.w); *(u32x2*)(KC + kr * 256 + lane * 4) = w;
            const float4 d4 = *(const float4*)(p.in[9] + crow * 256 + lane * 4);
            w.x = pk2(d4.x, d4.y); w.y = pk2(d4.z, d4.w); *(u32x2*)(VC + kr * 256 + lane * 4) = w;
        }
        {
            const float2 v = *(const float2*)(p.in[6] + crow * 128 + lane * 2);
            *(unsigned*)(CKVN + kr * 128 + lane * 2) = pk2(v.x, v.y);
        }
        if (lane < 16) {
            const float2 v = *(const float2*)(p.in[7] + crow * 32 + lane * 2);
            *(unsigned*)(KR + kr * 32 + lane * 2) = pk2(v.x, v.y);
        }
    }
}

constexpr int LSTR = 72;
struct Ring { int st; int primed; };
DI void gemm_stream2(const bf16_t* __restrict__ A, int lda, const bf16_t* __restrict__ Bt, int ldb, int K, int m0, int n0,
                     const bool has_next, const bf16_t* __restrict__ An, int ldan, const bf16_t* __restrict__ Btn, int ldbn, int m0n, int n0n,
                     char* smem, f32x4 (&acc)[4][4], const int tid, Ring& rg) {
    LAS char* lds = (LAS char*)smem;
    const int wave = __builtin_amdgcn_readfirstlane(tid >> 6), lane = tid & 63, wm = wave >> 1, wn = wave & 1, r = lane & 15, q = lane >> 4;
    const int sc0 = ((lane & 7) ^ (lane >> 4)) * 8, sc1 = ((lane & 7) ^ (4 | (lane >> 4))) * 8;
    const bf16_t* ga = A + (size_t)(m0 + wave * 32 + (lane >> 3)) * lda;
    const bf16_t* gb = Bt + (size_t)(n0 + wave * 16 + (lane >> 3)) * ldb;
    const bf16_t* gan = An + (size_t)(m0n + wave * 32 + (lane >> 3)) * ldan;
    const bf16_t* gbn = Btn + (size_t)(n0n + wave * 16 + (lane >> 3)) * ldbn;
    const unsigned wa = (unsigned)wave * 4096u, wbb = 32768u + (unsigned)wave * 2048u;
#define STAGE(ST, KT) { _Pragma("unroll") for (int i = 0; i < 4; ++i) \
            __builtin_amdgcn_global_load_lds((const unsigned*)(ga + (size_t)i * 8 * lda + (KT) * 64 + ((i & 1) ? sc1 : sc0)), (LAS unsigned*)(lds + (ST) * 49152 + wa + i * 1024), 16, 0, 0); \
        _Pragma("unroll") for (int i = 0; i < 2; ++i) \
            __builtin_amdgcn_global_load_lds((const unsigned*)(gb + (size_t)i * 8 * ldb + (KT) * 64 + ((i & 1) ? sc1 : sc0)), (LAS unsigned*)(lds + (ST) * 49152 + wbb + i * 1024), 16, 0, 0); }
    const int sw = r >> 1;
    const unsigned fo0 = (unsigned)(r * 128 + ((q ^ sw) << 4)), fo1 = (unsigned)(r * 128 + (((q ^ sw) ^ 4) << 4));
    const unsigned aoff = (unsigned)(wm * 64) * 128u, boff = 32768u + (unsigned)(wn * 64) * 128u;
    const int nk = K / 64;
    const int grp = wave >> 2;
#define PIECE(S2, G) { if ((G) < 4) __builtin_amdgcn_global_load_lds((const unsigned*)(pa + (size_t)(G) * 8 * plda + (((G) & 1) ? sc1 : sc0)), (LAS unsigned*)(lds + (S2) * 49152 + wa + (G) * 1024), 16, 0, 0); \
        else __builtin_amdgcn_global_load_lds((const unsigned*)(pb + (size_t)((G) - 4) * 8 * pldb + (((G) & 1) ? sc1 : sc0)), (LAS unsigned*)(lds + (S2) * 49152 + wbb + ((G) - 4) * 1024), 16, 0, 0); }
#define BAR() { __builtin_amdgcn_sched_barrier(0); __builtin_amdgcn_s_barrier(); asm volatile("" ::: "memory"); __builtin_amdgcn_sched_barrier(0); }
    int st = rg.st;
    if (!rg.primed) {
        const int s1p = st == 2 ? 0 : st + 1;
        BAR();
        STAGE(st, 0);
        STAGE(s1p, 1);
        asm volatile("s_waitcnt vmcnt(6)" ::: "memory");
        BAR();
    }
    if (grp == 1) BAR();
    for (int kt = 0; kt < nk; ++kt) {
        const bool pf = (kt + 2 < nk) || has_next, more = (kt + 1 < nk) || has_next;
        const bf16_t* pa = (kt + 2 < nk) ? ga + (kt + 2) * 64 : gan + (kt + 2 - nk) * 64;
        const bf16_t* pb = (kt + 2 < nk) ? gb + (kt + 2) * 64 : gbn + (kt + 2 - nk) * 64;
        const int plda = (kt + 2 < nk) ? lda : ldan, pldb = (kt + 2 < nk) ? ldb : ldbn;
        const int s2 = st >= 1 ? st - 1 : 2;
        const LAS char* base = lds + st * 49152;
#pragma unroll
        for (int ks = 0; ks < 2; ++ks) {
            const unsigned fo = ks ? fo1 : fo0;
            bf16x8 af[4], bfr[4];
#pragma unroll
            for (int i = 0; i < 4; ++i) { af[i] = *(const LAS bf16x8*)(base + aoff + i * 2048 + fo); bfr[i] = *(const LAS bf16x8*)(base + boff + i * 2048 + fo); }
            if (ks == 1 && more) { if (pf) asm volatile("s_waitcnt vmcnt(3)" ::: "memory"); else asm volatile("s_waitcnt vmcnt(0)" ::: "memory"); }
            if (pf) { PIECE(s2, ks * 3 + 0); PIECE(s2, ks * 3 + 1); PIECE(s2, ks * 3 + 2); }
            asm volatile("s_waitcnt lgkmcnt(0)" ::: "memory");
            BAR();
            __builtin_amdgcn_s_setprio(1);
#pragma unroll
            for (int mi = 0; mi < 4; ++mi)
#pragma unroll
                for (int ni = 0; ni < 4; ++ni) acc[mi][ni] = __builtin_amdgcn_mfma_f32_16x16x32_bf16(bfr[ni], af[mi], acc[mi][ni], 0, 0, 0);
            __builtin_amdgcn_s_setprio(0);
            BAR();
        }
        st = st == 2 ? 0 : st + 1;
    }
    if (grp == 0) BAR();
    rg.st = st; rg.primed = has_next ? 1 : 0;
#undef PIECE
#undef BAR
#undef STAGE
}

DI void gemm_stream(const bf16_t* __restrict__ A, int lda, const bf16_t* __restrict__ Bt, int ldb, int K, int m0, int n0, const bool has_next, int m0n, int n0n,
                    char* smem, f32x4 (&acc)[4][4], const int tid, Ring& rg) {
    gemm_stream2(A, lda, Bt, ldb, K, m0, n0, has_next, A, lda, Bt, ldb, m0n, n0n, smem, acc, tid, rg);
}
DI void gemm_mainloop(const bf16_t* __restrict__ A, int lda, const bf16_t* __restrict__ Bt, int ldb, int K, int m0, int n0, char* smem, f32x4 (&acc)[4][4], const int tid) {
    Ring rg; rg.st = 0; rg.primed = 0;
    gemm_stream(A, lda, Bt, ldb, K, m0, n0, false, m0, n0, smem, acc, tid, rg);
}

struct TileIter {
    int L, end, step, ntm, ntn;
    DI void init(int ntm_, int ntn_, int bid, int nb) {
        ntm = ntm_; ntn = ntn_;
        const int nt = ntm * ntn;
        if ((nb & 7) == 0) { const int x = bid & 7, per = (nt + 7) >> 3; L = x * per + (bid >> 3); end = min((x + 1) * per, nt); step = nb >> 3; }
        else { L = bid; end = nt; step = nb; }
    }
    DI bool next(int& tm, int& tn) {
        if (L >= end) return false;
        const int gsz = 8 * ntn, grp = L / gsz, rem = L - grp * gsz, rows = min(8, ntm - grp * 8);
        tn = rem / rows; tm = grp * 8 + (rem - tn * rows);
        L += step; return true;
    }
};

DI void zero_acc(f32x4 (&acc)[4][4]) {
#pragma unroll
    for (int i = 0; i < 4; ++i)
#pragma unroll
        for (int j = 0; j < 4; ++j) acc[i][j] = (f32x4){0.f, 0.f, 0.f, 0.f};
}

DI void gemm_gu(const Params& p, size_t woff, int bid, int nb, char* smem, const int tid) {
    const bf16_t* A = (const bf16_t*)(p.ws + B_XN);
    const bf16_t* Bt = (const bf16_t*)(p.ws + woff);
    bf16_t* ACT = (bf16_t*)(p.ws + B_ACT);
    const int ntn = 44, ntiles = 130 * ntn;
    const int lane = tid & 63, wave = __builtin_amdgcn_readfirstlane(tid >> 6), wm = wave >> 1, wn = wave & 1, r = lane & 15, q = lane >> 4;
    TileIter ti; ti.init(65, ntn, bid, nb);
    int tm, tn, tm2 = 0, tn2 = 0;
    bool have = ti.next(tm, tn);
    Ring rg; rg.st = 0; rg.primed = 0;
    for (; have; tm = tm2, tn = tn2) {
        have = ti.next(tm2, tn2);
        const int m0 = tm * 256, n0 = tn * 128;
        f32x4 acc[4][4]; zero_acc(acc);
        gemm_stream(A, 1024, Bt, 1024, 1024, m0, n0, have, tm2 * 256, tn2 * 128, smem, acc, tid, rg);
        const int nb0 = n0 + wn * 64;
#pragma unroll
        for (int mi = 0; mi < 4; ++mi) {
            const int row = m0 + wm * 64 + mi * 16 + r;
#pragma unroll
            for (int pr = 0; pr < 2; ++pr) {
                const f32x4 g = acc[mi][2 * pr], u = acc[mi][2 * pr + 1];
                float o[4];
#pragma unroll
                for (int j = 0; j < 4; ++j) o[j] = g[j] * __builtin_amdgcn_rcpf(1.0f + __builtin_amdgcn_exp2f(-LOG2E * g[j])) * u[j];
                const int col = ((nb0 + pr * 32) >> 5) * 16 + q * 4;
                u32x2 w; w.x = pk2(o[0], o[1]); w.y = pk2(o[2], o[3]);
                *(u32x2*)(ACT + (size_t)row * DFF + col) = w;
            }
        }
    }
}

template <int MODE>
DI void epi_y(const Params& p, const f32x4 (&acc)[4][4], int m0, int n0, const int tid, const int part = 0) {
    bf16_t* Y = (bf16_t*)(p.ws + B_Y);
    float* YS = (float*)(p.ws + B_YS);
    const int lane = tid & 63, wave = __builtin_amdgcn_readfirstlane(tid >> 6), wm = wave >> 1, wn = wave & 1, r = lane & 15, q = lane >> 4;
#pragma unroll
    for (int mi = 0; mi < 4; ++mi) {
        const int row = m0 + wm * 64 + mi * 16 + r;
#pragma unroll
        for (int ni = 0; ni < 4; ++ni) {
            const int col = n0 + wn * 64 + ni * 16 + q * 4;
            if (MODE == 0) {
                u32x2 w; w.x = pk2(acc[mi][ni][0], acc[mi][ni][1]); w.y = pk2(acc[mi][ni][2], acc[mi][ni][3]);
                *(u32x2*)(Y + (size_t)row * DM + col) = w;
            } else if (MODE == 1) {
                *(f32x4*)(YS + (size_t)(row - NP) * DM + col) = acc[mi][ni];
            } else {
                *(f32x4*)(YS + (size_t)part * NS * DM + (size_t)(row - NP) * DM + col) = acc[mi][ni];
            }
        }
    }
}

DI void gemm_y(const Params& p, const bf16_t* A, int lda, size_t woff, int K, int kper, int bid, int nb, char* smem, const int tid) {
    const bf16_t* Bt = (const bf16_t*)(p.ws + woff);
    TileIter ti; ti.init(64, 8, bid, nb);
    int tm, tn, tm2 = 0, tn2 = 0;
    bool have = ti.next(tm, tn);
    Ring rg; rg.st = 0; rg.primed = 0;
    for (; have; tm = tm2, tn = tn2) {
        have = ti.next(tm2, tn2);
        const int m0 = tm * 256, n0 = tn * 128;
        f32x4 acc[4][4]; zero_acc(acc);
        gemm_stream(A, lda, Bt, K, K, m0, n0, have, tm2 * 256, tn2 * 128, smem, acc, tid, rg);
        epi_y<0>(p, acc, m0, n0, tid);
    }
    const int S = (K / 64) / kper;
    for (int u = bid; u < 8 * S; u += nb) {
        const int tile = u / S, part = u - tile * S, m0 = NP, n0 = tile * 128;
        f32x4 acc[4][4]; zero_acc(acc);
        gemm_mainloop(A + part * kper * 64, lda, Bt + part * kper * 64, K, kper * 64, m0, n0, smem, acc, tid);
        epi_y<2>(p, acc, m0, n0, tid, part);
    }
}

DI void gemm_ple(const Params& p, int bid, int nb, char* smem, const int tid) {
    const bf16_t* XN = (const bf16_t*)(p.ws + B_XN);
    const bf16_t* PB = (const bf16_t*)(p.ws + W_PBF);
    const bf16_t* WG = (const bf16_t*)(p.ws + W_PG);
    const bf16_t* WP = (const bf16_t*)(p.ws + W_PP);
    const int ntn = 8, ntiles = 130 * ntn;
    TileIter ti; ti.init(65, ntn, bid, nb);
    int tm, tn, tm2 = 0, tn2 = 0;
    bool have = ti.next(tm, tn);
    Ring rg; rg.st = 0; rg.primed = 0;
    for (; have; tm = tm2, tn = tn2) {
        have = ti.next(tm2, tn2);
        const int m0 = tm * 256, n0 = tn * 128;
        u32x2 gpk[4][4];
        {
            f32x4 gate[4][4]; zero_acc(gate);
            gemm_stream2(XN, 1024, WG, 1024, 1024, m0, n0, true, PB, 256, WP, 256, m0, n0, smem, gate, tid, rg);
#pragma unroll
            for (int i = 0; i < 4; ++i)
#pragma unroll
                for (int j = 0; j < 4; ++j) {
                    float g[4];
#pragma unroll
                    for (int e = 0; e < 4; ++e) g[e] = __builtin_amdgcn_rcpf(1.0f + __builtin_amdgcn_exp2f(-LOG2E * gate[i][j][e]));
                    gpk[i][j].x = pk2(g[0], g[1]); gpk[i][j].y = pk2(g[2], g[3]);
                }
        }
        f32x4 acc[4][4]; zero_acc(acc);
        gemm_stream2(PB, 256, WP, 256, 256, m0, n0, have, XN, 1024, WG, 1024, tm2 * 256, tn2 * 128, smem, acc, tid, rg);
#pragma unroll
        for (int i = 0; i < 4; ++i)
#pragma unroll
            for (int j = 0; j < 4; ++j) {
                acc[i][j][0] *= __uint_as_float(gpk[i][j].x << 16); acc[i][j][1] *= __uint_as_float(gpk[i][j].x & 0xffff0000u);
                acc[i][j][2] *= __uint_as_float(gpk[i][j].y << 16); acc[i][j][3] *= __uint_as_float(gpk[i][j].y & 0xffff0000u);
            }
        if (m0 < NP) epi_y<0>(p, acc, m0, n0, tid); else epi_y<1>(p, acc, m0, n0, tid);
    }
}

DI void gemm_in(const Params& p, int l, int bid, int nb, char* smem, const int tid) {
    const bf16_t* A = (const bf16_t*)(p.ws + B_XN);
    const bf16_t* Bt = (const bf16_t*)(p.ws + W_IN);
    const int ntn = 16, ntiles = 130 * ntn;
    const int lane = tid & 63, wave = __builtin_amdgcn_readfirstlane(tid >> 6), wm = wave >> 1, wn = wave & 1, r = lane & 15, q = lane >> 4;
    TileIter ti; ti.init(65, ntn, bid, nb);
    int tm, tn, tm2 = 0, tn2 = 0;
    bool have = ti.next(tm, tn);
    Ring rg; rg.st = 0; rg.primed = 0;
    for (; have; tm = tm2, tn = tn2) {
        have = ti.next(tm2, tn2);
        const int m0 = tm * 256, n0 = tn * 128;
        f32x4 acc[4][4]; zero_acc(acc);
        gemm_stream(A, 1024, Bt, 1024, 1024, m0, n0, have, tm2 * 256, tn2 * 128, smem, acc, tid, rg);
        const int nb0 = n0 + wn * 64;
        const int seg = nb0 >> 8;
        const int cin = nb0 & 255;
        if (seg == 0 || seg == 3) {
            bf16_t* Q = (bf16_t*)(p.ws + (seg == 0 ? B_QA : B_QC));
#pragma unroll
            for (int mi = 0; mi < 4; ++mi) {
                const int row = m0 + wm * 64 + mi * 16 + r;
#pragma unroll
                for (int ni = 0; ni < 4; ++ni) {
                    u32x2 w; w.x = pk2(acc[mi][ni][0], acc[mi][ni][1]); w.y = pk2(acc[mi][ni][2], acc[mi][ni][3]);
                    *(u32x2*)(Q + (size_t)row * 256 + cin + ni * 16 + q * 4) = w;
                }
            }
        } else if (seg < 6) {
            const size_t boff = seg == 1 ? B_KA : seg == 2 ? B_VA : seg == 4 ? B_KC : B_VC;
            const bool samp = m0 >= NP;
            const size_t ooff = samp ? (seg == 1 ? O_AKS : seg == 2 ? O_AVS : seg == 4 ? O_CKS : O_CVS) : (seg == 1 ? O_AKP : seg == 2 ? O_AVP : seg == 4 ? O_CKP : O_CVP);
            bf16_t* KV = (bf16_t*)(p.ws + boff);
#pragma unroll
            for (int mi = 0; mi < 4; ++mi) {
                const int row = m0 + wm * 64 + mi * 16 + r;
                const size_t srow = samp ? (size_t)(l * NS + (row - NP)) : (size_t)(l * NP + row);
                const size_t kr = (size_t)krow_of(row);
#pragma unroll
                for (int ni = 0; ni < 4; ++ni) {
                    const int c = cin + ni * 16 + q * 4;
                    *(f32x4*)(p.out + ooff + srow * 256 + c) = acc[mi][ni];
                    u32x2 w; w.x = pk2(acc[mi][ni][0], acc[mi][ni][1]); w.y = pk2(acc[mi][ni][2], acc[mi][ni][3]);
                    *(u32x2*)(KV + kr * 256 + c) = w;
                }
            }
        } else {
            float* SM = (float*)(p.ws + B_SMALL);
#pragma unroll
            for (int mi = 0; mi < 4; ++mi) {
                const int row = m0 + wm * 64 + mi * 16 + r;
#pragma unroll
                for (int ni = 0; ni < 4; ++ni) *(f32x4*)(SM + (size_t)row * 512 + (nb0 - 1536) + ni * 16 + q * 4) = acc[mi][ni];
            }
        }
    }
}

DI void gemm_uqkv(const Params& p, int bid, int nb, char* smem, const int tid) {
    const int lane = tid & 63, wave = __builtin_amdgcn_readfirstlane(tid >> 6), wm = wave >> 1, wn = wave & 1, r = lane & 15, q = lane >> 4;
    const int nuq = 65 * 6, nukv = (KALL / 256) * 8;
    const bf16_t* CQN = (const bf16_t*)(p.ws + B_CQN); const bf16_t* WUQ = (const bf16_t*)(p.ws + W_UQ);
    const bf16_t* CKV = (const bf16_t*)(p.ws + B_CKVN); const bf16_t* WUKV = (const bf16_t*)(p.ws + W_UKV);
    Ring rg; rg.st = 0; rg.primed = 0;
    for (int t = bid; t < nuq + nukv; t += nb) {
        f32x4 acc[4][4]; zero_acc(acc);
        const int t2 = t + nb;
        const bool hn = t2 < nuq + nukv, nuqn = t2 < nuq;
        const int u2 = nuqn ? t2 : t2 - nuq;
        const int m0n = (nuqn ? u2 / 6 : u2 / 8) * 256, n0n = (nuqn ? u2 % 6 : u2 % 8) * 128;
        const bf16_t* An = nuqn ? CQN : CKV; const bf16_t* Btn = nuqn ? WUQ : WUKV; const int ldn = nuqn ? 256 : 128;
        if (t < nuq) {
            const int tm = t / 6, tn = t % 6, m0 = tm * 256, n0 = tn * 128;
            gemm_stream2(CQN, 256, WUQ, 256, 256, m0, n0, hn, An, ldn, Btn, ldn, m0n, n0n, smem, acc, tid, rg);
            bf16_t* QB = (bf16_t*)(p.ws + B_QB);
            const int nb0 = n0 + wn * 64, f0 = nb0 >> 4;
#pragma unroll
            for (int mi = 0; mi < 4; ++mi) {
                const int row = m0 + wm * 64 + mi * 16 + r;
                const int pos = row < NP ? (row & (SEQ - 1)) : PAST + ((row - NP) & 31);
#pragma unroll
                for (int pr = 0; pr < 2; ++pr) {
                    f32x4 a = acc[mi][2 * pr], b = acc[mi][2 * pr + 1];
                    if ((f0 + 2 * pr) % 6 == 4) {
#pragma unroll
                        for (int j = 0; j < 4; ++j) {
                            float c, s; rope_cs(pos, q * 4 + j, c, s);
                            const float x1 = a[j], x2 = b[j];
                            a[j] = x1 * c - x2 * s; b[j] = x1 * s + x2 * c;
                        }
                    }
                    u32x2 w; w.x = pk2(a[0], a[1]); w.y = pk2(a[2], a[3]);
                    *(u32x2*)(QB + (size_t)row * 768 + nb0 + pr * 32 + q * 4) = w;
                    w.x = pk2(b[0], b[1]); w.y = pk2(b[2], b[3]);
                    *(u32x2*)(QB + (size_t)row * 768 + nb0 + pr * 32 + 16 + q * 4) = w;
                }
            }
        } else {
            const int t2 = t - nuq, tm = t2 / 8, tn = t2 % 8, m0 = tm * 256, n0 = tn * 128;
            gemm_stream2(CKV, 128, WUKV, 128, 128, m0, n0, hn, An, ldn, Btn, ldn, m0n, n0n, smem, acc, tid, rg);
            bf16_t* KVB = (bf16_t*)(p.ws + B_KVB);
#pragma unroll
            for (int mi = 0; mi < 4; ++mi) {
                const int row = m0 + wm * 64 + mi * 16 + r;
#pragma unroll
                for (int ni = 0; ni < 4; ++ni) {
                    u32x2 w; w.x = pk2(acc[mi][ni][0], acc[mi][ni][1]); w.y = pk2(acc[mi][ni][2], acc[mi][ni][3]);
                    *(u32x2*)(KVB + (size_t)row * 1024 + n0 + wn * 64 + ni * 16 + q * 4) = w;
                }
            }
        }
    }
}

constexpr int KSTR = 104;
constexpr int VSTR = 68;
struct AttnItem {
    const bf16_t* Q; int ldq;
    const bf16_t* K; int ldk;
    const bf16_t* KR;
    const bf16_t* V; int ldv;
    const float* F;
    float* O;
    int nq, qpos0, Tk, ntiles;
};

template <int MODE, bool MASKED>
DI void attn_scores(const f32x4 (&s)[4], float (&pw)[4][4], const int kt, const int q, const int qpos, const int Tk, const LAS float* sF, const float sc,
                    float& m, float& lsum, float& R, f32x4 (&o)[4]) {
    if (MODE == 0) {
        float e[4][4], hq[4], T[4];
#pragma unroll
        for (int st = 0; st < 4; ++st) {
            float lv[4];
#pragma unroll
            for (int j = 0; j < 4; ++j) {
                const int key = kt * 64 + st * 16 + q * 4 + j;
                const float z = s[st][j] * sc;
                const bool valid = !MASKED || key < qpos;
                lv[j] = valid ? -(fmaxf(z, 0.f) + __logf(1.0f + __expf(-fabsf(z)))) : 0.f;
                pw[st][j] = valid ? z + lv[j] : -1e30f;
            }
            e[st][3] = 0.f; e[st][2] = lv[3]; e[st][1] = lv[3] + lv[2]; e[st][0] = lv[3] + lv[2] + lv[1];
            const float tot = e[st][0] + lv[0];
            float a16, b16, a32, b32;
            swap16(tot, a16, b16);
            const float pr = a16 + b16;
            swap32(pr, a32, b32);
            T[st] = a32 + b32;
            hq[st] = ((q & 1) == 0 ? b16 : 0.f) + ((q & 2) == 0 ? b32 : 0.f);
        }
        float after = 0.f;
#pragma unroll
        for (int st = 3; st >= 0; --st) {
#pragma unroll
            for (int j = 0; j < 4; ++j) {
                const float arg = pw[st][j] + (R + after + hq[st] + e[st][j]);
                pw[st][j] = (!MASKED || pw[st][j] > -1e29f) ? __expf(arg) : 0.f;
            }
            after += T[st];
        }
        R += after;
    } else {
        float mx = -1e30f;
#pragma unroll
        for (int st = 0; st < 4; ++st) {
            f32x4 fv = (f32x4){0.f, 0.f, 0.f, 0.f};
            if (MODE == 2) fv = *(const LAS f32x4*)(sF + st * 16 + q * 4);
#pragma unroll
            for (int j = 0; j < 4; ++j) {
                const int key = kt * 64 + st * 16 + q * 4 + j;
                const bool valid = !MASKED || ((key < Tk) && (MODE == 1 ? ((key >> 6) <= (qpos >> 6)) : (key <= qpos)));
                const float z = s[st][j] * (sc * LOG2E) - fv[j];
                pw[st][j] = valid ? z : -1e30f;
                mx = fmaxf(mx, pw[st][j]);
            }
        }
        { float a, b; swap16(mx, a, b); mx = fmaxf(a, b); swap32(mx, a, b); mx = fmaxf(a, b); }
        const float mn = fmaxf(m, mx);
        const float alpha = __builtin_amdgcn_exp2f(m - mn);
        m = mn;
        float ps = 0.f;
#pragma unroll
        for (int st = 0; st < 4; ++st)
#pragma unroll
            for (int j = 0; j < 4; ++j) {
                const float pv = (!MASKED || pw[st][j] > -1e29f) ? __builtin_amdgcn_exp2f(pw[st][j] - mn) : 0.f;
                pw[st][j] = pv; ps += pv;
            }
        lsum = lsum * alpha + ps;
#pragma unroll
        for (int i = 0; i < 4; ++i) o[i] = o[i] * alpha;
    }
}

template <int MODE>
DI void attn_item(const AttnItem& a, char* smem, const int tid) {
    constexpr int DQK = MODE == 1 ? 96 : 64, NKS = DQK / 32;
    constexpr unsigned KOFF = 0, VOFF = 8192, KROFF = 16384, FOFF = 20480, ASTG = 21504;
    LAS char* lds = (LAS char*)smem;
    const int wave = __builtin_amdgcn_readfirstlane(tid >> 6), lane = tid & 63, r = lane & 15, q = lane >> 4;
    const int qi = wave * 16 + r;
    const int qic = qi < a.nq ? qi : a.nq - 1;
    const int qpos = a.qpos0 + qic;
    bf16x8 qf[NKS];
#pragma unroll
    for (int ks = 0; ks < NKS; ++ks) qf[ks] = *(const bf16x8*)(a.Q + (size_t)qic * a.ldq + ks * 32 + q * 8);
    f32x4 o[4];
#pragma unroll
    for (int i = 0; i < 4; ++i) o[i] = (f32x4){0.f, 0.f, 0.f, 0.f};
    float m = -1e30f, lsum = 0.f, R = 0.f;
    const float sc = MODE == 1 ? 0.10206207261596575f : 0.125f;
    const int srow8 = lane >> 3;
    const int sf = (((srow8 >> 1) & 1) << 2) | (((srow8 >> 2) & 1) << 1);
    const int schunk = (lane & 7) ^ sf;
    const int kchunk = (lane & 7) ^ (((wave & 1) << 2) | (srow8 >> 1));
    const unsigned wb = (unsigned)wave * 1024u;
#define ASTAGE(ST, KT) { \
        { int key = (KT) * 64 + wave * 8 + srow8; key = key < a.Tk ? key : a.Tk - 1; \
            __builtin_amdgcn_global_load_lds((const unsigned*)(a.K + (size_t)key * a.ldk + kchunk * 8), (LAS unsigned*)(lds + (ST) * ASTG + KOFF + wb), 16, 0, 0); \
            __builtin_amdgcn_global_load_lds((const unsigned*)(a.V + (size_t)key * a.ldv + schunk * 8), (LAS unsigned*)(lds + (ST) * ASTG + VOFF + wb), 16, 0, 0); } \
        if (MODE == 1 && wave < 4) { int key = (KT) * 64 + wave * 16 + (lane >> 2); key = key < a.Tk ? key : a.Tk - 1; \
            __builtin_amdgcn_global_load_lds((const unsigned*)(a.KR + (size_t)key * 32 + ((lane & 3) ^ (((lane >> 5) & 1) << 1)) * 8), (LAS unsigned*)(lds + (ST) * ASTG + KROFF + (unsigned)wave * 1024u), 16, 0, 0); } }
    const int fr_ = (((r >> 1) & 1) << 2) | (((r >> 2) & 1) << 1);
    const unsigned ko0 = (unsigned)(r * 128 + ((q ^ (r >> 1)) << 4)), ko1 = (unsigned)(r * 128 + (((4 + q) ^ (r >> 1)) << 4)), ko2 = (unsigned)(r * 64 + ((q ^ (((r >> 3) & 1) << 1)) << 4));
    const int qq = r >> 2, pp = r & 3;
    const int vf_ = (((qq >> 1) & 1) << 2) | ((q & 1) << 1);
    const unsigned vbase = (unsigned)((q * 4 + qq) * 128 + (pp & 1) * 8);
    __syncthreads();
    {
        const int kt0 = MODE == 0 ? (a.ntiles - 1) : 0;
        ASTAGE(0, kt0);
        if (MODE == 2 && tid < 64) { int key = kt0 * 64 + tid; key = key < a.Tk ? key : a.Tk - 1; *(LAS float*)(lds + FOFF + tid * 4) = a.F[(size_t)key * 4] * LOG2E; }
    }
    for (int it = 0; it < a.ntiles; ++it) {
        const int kt = MODE == 0 ? (a.ntiles - 1 - it) : it;
        const int st_ = it & 1;
        asm volatile("s_waitcnt vmcnt(0)" ::: "memory");
        __syncthreads();
        if (MODE == 0 && it > 0) {
            const LAS unsigned* fl = (const LAS unsigned*)(lds + 2 * ASTG + ((it - 1) & 1) * 64);
            unsigned all = 1u;
#pragma unroll
            for (int w = 0; w < NWAVE; ++w) all &= fl[w];
            if (all) break;
        }
        float fnext = 0.f;
        if (it + 1 < a.ntiles) {
            const int ktn = MODE == 0 ? (kt - 1) : (kt + 1);
            ASTAGE(st_ ^ 1, ktn);
            if (MODE == 2 && tid < 64) { int key = ktn * 64 + tid; key = key < a.Tk ? key : a.Tk - 1; fnext = a.F[(size_t)key * 4] * LOG2E; }
        }
        const LAS char* sK = lds + st_ * ASTG + KOFF;
        const LAS char* sV = lds + st_ * ASTG + VOFF;
        const LAS char* sKR = lds + st_ * ASTG + KROFF;
        const LAS float* sF = (const LAS float*)(lds + st_ * ASTG + FOFF);
        const int qhi = a.qpos0 + min(wave * 16 + 15, a.nq - 1);
        const bool none = (wave * 16 >= a.nq) || (MODE == 0 ? (kt * 64 >= qhi) : MODE == 1 ? (kt > (qhi >> 6)) : (kt * 64 > qhi));
        if (!none) {
        f32x4 s[4];
#pragma unroll
        for (int st = 0; st < 4; ++st) {
            s[st] = (f32x4){0.f, 0.f, 0.f, 0.f};
            s[st] = __builtin_amdgcn_mfma_f32_16x16x32_bf16(*(const LAS bf16x8*)(sK + st * 2048 + ko0), qf[0], s[st], 0, 0, 0);
            s[st] = __builtin_amdgcn_mfma_f32_16x16x32_bf16(*(const LAS bf16x8*)(sK + st * 2048 + ko1), qf[1], s[st], 0, 0, 0);
            if (MODE == 1) s[st] = __builtin_amdgcn_mfma_f32_16x16x32_bf16(*(const LAS bf16x8*)(sKR + st * 1024 + ko2), qf[NKS - 1], s[st], 0, 0, 0);
        }
        float pw[4][4];
        bool full;
        {
            const int qlo = a.qpos0 + min(wave * 16, a.nq - 1), klast = kt * 64 + 63;
            full = MODE == 0 ? (klast < qlo) : (klast < a.Tk && (MODE == 1 ? (kt <= (qlo >> 6)) : (klast <= qlo)));
        }
        if (full) attn_scores<MODE, false>(s, pw, kt, q, qpos, a.Tk, sF, sc, m, lsum, R, o);
        else attn_scores<MODE, true>(s, pw, kt, q, qpos, a.Tk, sF, sc, m, lsum, R, o);
#pragma unroll
        for (int c = 0; c < 2; ++c) {
            u32x4 pk;
            pk.x = pk2(pw[2 * c][0], pw[2 * c][1]); pk.y = pk2(pw[2 * c][2], pw[2 * c][3]);
            pk.z = pk2(pw[2 * c + 1][0], pw[2 * c + 1][1]); pk.w = pk2(pw[2 * c + 1][2], pw[2 * c + 1][3]);
            const bf16x8 pf = __builtin_bit_cast(bf16x8, pk);
#pragma unroll
            for (int dt = 0; dt < 4; ++dt) {
                const unsigned co = (unsigned)(((dt * 2 + (pp >> 1)) ^ vf_) << 4);
                const s16x4 lo = __builtin_amdgcn_ds_read_tr16_b64_v4i16((LAS s16x4*)(sV + (2 * c) * 2048 + vbase + co));
                const s16x4 hi = __builtin_amdgcn_ds_read_tr16_b64_v4i16((LAS s16x4*)(sV + (2 * c + 1) * 2048 + vbase + co));
                const bf16x8 vf = __builtin_shufflevector(lo, hi, 0, 1, 2, 3, 4, 5, 6, 7);
                o[dt] = __builtin_amdgcn_mfma_f32_16x16x32_bf16(vf, pf, o[dt], 0, 0, 0);
            }
        }
        }
        if (MODE == 0) {
            const bool sat = (wave * 16 >= a.nq) || (__builtin_amdgcn_ballot_w64(R < -104.0f) == ~0ull);
            if (lane == 0) *(LAS unsigned*)(lds + 2 * ASTG + (it & 1) * 64 + wave * 4) = sat ? 1u : 0u;
        }
        if (MODE == 2 && tid < 64 && it + 1 < a.ntiles) *(LAS float*)(lds + (st_ ^ 1) * ASTG + FOFF + tid * 4) = fnext;
    }
#undef ASTAGE
    float inv = 1.0f;
    if (MODE != 0) {
        { float a, b; swap16(lsum, a, b); lsum = a + b; swap32(lsum, a, b); lsum = a + b; }
        inv = 1.0f / lsum;
    }
    if (qi < a.nq) {
#pragma unroll
        for (int dt = 0; dt < 4; ++dt) *(f32x4*)(a.O + (size_t)qi * 1024 + dt * 16 + q * 4) = o[dt] * inv;
    }
}

DI void attn_phase(const Params& p, int bid, int nb, char* smem, const int tid) {
    const bf16_t* QA = (const bf16_t*)(p.ws + B_QA); const bf16_t* QC = (const bf16_t*)(p.ws + B_QC); const bf16_t* QB = (const bf16_t*)(p.ws + B_QB);
    const bf16_t* KA = (const bf16_t*)(p.ws + B_KA); const bf16_t* VA = (const bf16_t*)(p.ws + B_VA);
    const bf16_t* KC = (const bf16_t*)(p.ws + B_KC); const bf16_t* VC = (const bf16_t*)(p.ws + B_VC);
    const bf16_t* KVB = (const bf16_t*)(p.ws + B_KVB); const bf16_t* KR = (const bf16_t*)(p.ws + B_KR);
    const float* Fall = (const float*)(p.ws + B_F);
    float* O = (float*)(p.ws + B_Y);
    const bool xmap = nb == 256;
    const int nrounds = xmap ? 9 : (128 + 2048 + nb - 1) / nb;
    for (int rnd = 0; rnd < nrounds; ++rnd) {
        int b, hs, qrow0, krow0, nq, qpos0, Tk, nt;
        if (xmap) {
            if (rnd < 8) {
                const int i = bid >> 3;
                int qb;
                if (rnd < 2) {
                    const int pi = i & 3;
                    hs = (i >> 2) & 3;
                    qb = i < 16 ? (rnd == 0 ? pi : 11 - pi) : (rnd == 0 ? 15 - pi : 4 + pi);
                } else {
                    const int L = ((i & 15) + 4 * (rnd >> 1)) & 15;
                    qb = (rnd & 1) ? 15 - L : L;
                    hs = 2 * rnd + (i >> 4);
                }
                b = bid & 7;
                qrow0 = b * SEQ + qb * 128; krow0 = b * SEQ; nq = 128; qpos0 = qb * 128; Tk = SEQ; nt = 2 * qb + 2;
            } else {
                if (bid >= 128) continue;
                b = bid & 7; hs = bid >> 3;
                qrow0 = NP + b * TS; krow0 = NP + b * TKS; nq = TS; qpos0 = PAST; Tk = TKS; nt = 17;
            }
        } else {
            const int k = rnd * nb + ((rnd & 1) ? (nb - 1 - bid) : bid);
            if (k >= 128 + 2048) continue;
            if (k >= 1024 && k < 1152) { const int it = k - 1024; b = it >> 4; hs = it & 15; qrow0 = NP + b * TS; krow0 = NP + b * TKS; nq = TS; qpos0 = PAST; Tk = TKS; nt = 17; }
            else { const int j = k < 1024 ? k : k - 128; const int qb = 15 - (j >> 7); b = (j >> 4) & 7; hs = ((j & 15) + 5 * (j >> 7)) & 15; qrow0 = b * SEQ + qb * 128; krow0 = b * SEQ; nq = 128; qpos0 = qb * 128; Tk = SEQ; nt = 2 * qb + 2; }
        }
        AttnItem a;
        a.nq = nq; a.qpos0 = qpos0; a.Tk = Tk; a.ntiles = nt; a.KR = nullptr; a.F = nullptr;
        if (hs < 8) {
            a.Q = QB + (size_t)qrow0 * 768 + hs * 96; a.ldq = 768;
            a.K = KVB + (size_t)krow0 * 1024 + hs * 128; a.ldk = 1024; a.KR = KR + (size_t)krow0 * 32;
            a.V = KVB + (size_t)krow0 * 1024 + hs * 128 + 64; a.ldv = 1024;
            a.O = O + (size_t)qrow0 * 1024 + 256 + hs * 64;
            attn_item<1>(a, smem, tid);
        } else if (hs < 12) {
            const int h = hs - 8;
            a.Q = QA + (size_t)qrow0 * 256 + h * 64; a.ldq = 256;
            a.K = KA + (size_t)krow0 * 256 + h * 64; a.ldk = 256;
            a.V = VA + (size_t)krow0 * 256 + h * 64; a.ldv = 256;
            a.O = O + (size_t)qrow0 * 1024 + h * 64;
            attn_item<0>(a, smem, tid);
        } else {
            const int h = hs - 12;
            a.Q = QC + (size_t)qrow0 * 256 + h * 64; a.ldq = 256;
            a.K = KC + (size_t)krow0 * 256 + h * 64; a.ldk = 256;
            a.V = VC + (size_t)krow0 * 256 + h * 64; a.ldv = 256;
            a.F = Fall + (size_t)krow0 * 4 + h;
            a.O = O + (size_t)qrow0 * 1024 + 768 + h * 64;
            attn_item<2>(a, smem, tid);
        }
    }
}


#define XB_TMO      128
#define XB_XCNT(j)  (256  + 64 * (j))
#define XB_XSUB(j)  (1280 + 64 * (j))
#define XB_XGEN(j)  (2304 + 64 * (j))
#define XB_TOP      3328
#define XB_TOPGEN   3392
#define XCD_BAR_WORDS 3456
#define XB_SPIN_CAP (1u << 22)
DI unsigned xb_ld(unsigned* p) { return __hip_atomic_load(p, __ATOMIC_RELAXED, __HIP_MEMORY_SCOPE_AGENT); }
DI unsigned xb_add(unsigned* p, unsigned v) { return __hip_atomic_fetch_add(p, v, __ATOMIC_RELAXED, __HIP_MEMORY_SCOPE_AGENT); }
DI unsigned xb_xcc_id() { return (unsigned)__builtin_amdgcn_s_getreg((3 << 11) | 20) & 0xFu; }
#define XB_SPIN(cond, bar) do { unsigned _sp = 0; while (cond) { __builtin_amdgcn_s_sleep(1); \
    if ((++_sp & 255u) == 0u) { if (xb_ld(&(bar)[XB_TMO])) break; if (_sp > XB_SPIN_CAP) { atomicAdd(&(bar)[XB_TMO], 1u); break; } } } } while (0)
struct XcdBarrier { unsigned* bar; unsigned x; volatile LAS unsigned* st; };
DI XcdBarrier xcd_barrier_post(unsigned* bar, volatile LAS unsigned* st) {
    XcdBarrier b; b.bar = bar; b.x = xb_xcc_id(); b.st = st;
    if (threadIdx.x == 0) (void)xb_add(&bar[XB_XCNT(b.x)], 1u);
    return b;
}
DI void xcd_barrier_complete(unsigned* bar, unsigned x, unsigned& nloc, unsigned& nx) {
    const unsigned G = gridDim.x * gridDim.y * gridDim.z;
    unsigned sum, cnt, mine, sp = 0u;
    for (;;) {
        sum = 0u; cnt = 0u; mine = 0u;
#pragma unroll
        for (unsigned j = 0; j < 16; ++j) { const unsigned c = xb_ld(&bar[XB_XCNT(j)]); sum += c; cnt += (c > 0u) ? 1u : 0u; mine = (j == x) ? c : mine; }
        if (sum == G) break;
        __builtin_amdgcn_s_sleep(1);
        if ((++sp & 255u) == 0u) { if (xb_ld(&bar[XB_TMO])) break; if (sp > XB_SPIN_CAP) { atomicAdd(&bar[XB_TMO], 1u); break; } }
    }
    nloc = mine > 0u ? mine : 1u; nx = cnt > 0u ? cnt : 1u;
}
DI void xcd_barrier(const XcdBarrier& b) {
    asm volatile("s_waitcnt vmcnt(0)" ::: "memory");
    __syncthreads();
    if (threadIdx.x == 0) {
        unsigned* bar = b.bar;
        __builtin_amdgcn_s_waitcnt(0);
        unsigned nloc = b.st[0], nx = b.st[1];
        if (nloc == 0u) { xcd_barrier_complete(bar, b.x, nloc, nx); b.st[0] = nloc; b.st[1] = nx; }
        const unsigned old = xb_add(&bar[XB_XSUB(b.x)], 1u);
        const unsigned gen = old / nloc;
        if (old + 1u == (gen + 1u) * nloc) {
            __builtin_amdgcn_fence(__ATOMIC_RELEASE, "agent");
            asm volatile("s_waitcnt vmcnt(0)" ::: "memory");
            const unsigned og = xb_add(&bar[XB_TOP], 1u);
            const unsigned tg = og / nx;
            if (og + 1u == (tg + 1u) * nx) xb_add(&bar[XB_TOPGEN], 1u);
            else XB_SPIN(xb_ld(&bar[XB_TOPGEN]) == tg, bar);
            __builtin_amdgcn_fence(__ATOMIC_ACQUIRE, "agent");
            xb_add(&bar[XB_XGEN(b.x)], 1u);
            asm volatile("s_waitcnt vmcnt(0)" ::: "memory");
        } else {
            XB_SPIN(xb_ld(&bar[XB_XGEN(b.x)]) == gen, bar);
            __builtin_amdgcn_fence(__ATOMIC_ACQUIRE, "agent");
            asm volatile("s_waitcnt vmcnt(0)" ::: "memory");
        }
    }
    __syncthreads();
}

constexpr int NPHASE = 31;
DI void run_phase(const Params& pk, int ph, int bid_, int nb, char* smem) {
    int tid = threadIdx.x; asm volatile("" : "+v"(tid));
    int bid = bid_; asm volatile("" : "+s"(bid));
    Params p = pk;
    asm volatile("" : "+s"(p.ws));
    asm volatile("" : "+s"(p.out));
    if (ph == 0) {
        prep_phase(p, 0, bid, nb, smem, tid);
        rowpass(p, true, 0.f, nullptr, p.in[11], 1, bid, nb, tid);
        return;
    }
    const int l = (ph - 1) / 15, s = (ph - 1) % 15;
    switch (s) {
    case 0: gemm_gu(p, W_GU1, bid, nb, smem, tid); break;
    case 1: gemm_y(p, (const bf16_t*)(p.ws + B_ACT), DFF, W_DN1, DFF, 4, bid, nb, smem, tid); break;
    case 2: rowpass(p, false, 0.5f, p.in[12] + l * DM, p.in[15] + l * DM, 11, bid, nb, tid); break;
    case 3: gemm_in(p, l, bid, nb, smem, tid); break;
    case 4: post_phase(p, l, bid, nb, tid); break;
    case 5: gemm_uqkv(p, bid, nb, smem, tid); break;
    case 6: attn_phase(p, bid, nb, smem, tid); break;
    case 7: onorm_pass(p, p.in[23] + l * DM, bid, nb, tid); break;
    case 8: gemm_y(p, (const bf16_t*)(p.ws + B_XN), DM, W_OUT, DM, 2, bid, nb, smem, tid); break;
    case 9: rowpass(p, false, 1.0f, p.in[16] + l * DM, p.in[25] + l * DM, 8, bid, nb, tid); break;
    case 10: gemm_gu(p, W_GU2, bid, nb, smem, tid); break;
    case 11: gemm_y(p, (const bf16_t*)(p.ws + B_ACT), DFF, W_DN2, DFF, 4, bid, nb, smem, tid); break;
    case 12: rowpass(p, false, 0.5f, p.in[26] + l * DM, p.in[29] + l * DM, 11, bid, nb, tid); break;
    case 13: gemm_ple(p, bid, nb, smem, tid); break;
    case 14:
        rowpass(p, false, 1.0f, p.in[32] + l * DM, l == 0 ? p.in[11] + DM : nullptr, 1, bid, nb, tid);
        if (l == 0) prep_phase(p, 1, bid, nb, smem, tid);
        break;
    }
}

extern "C" __global__ void __launch_bounds__(512, 2) fwd_kernel(Params p, int ph0, int ph1) {
    extern __shared__ __attribute__((aligned(16))) char smem[];
#if MEGA
    __shared__ uint4 xb_words;
    if (threadIdx.x == 0) xb_words = make_uint4(0u, 0u, 0u, 0u);
    __syncthreads();
    XcdBarrier xb = xcd_barrier_post((unsigned*)(p.ws + B_BAR), (volatile LAS unsigned*)&xb_words);
    if (ph1 > 100000) cg::this_grid().sync();
#ifdef PROBE_DUP
    for (int pp = 2 * ph0; pp < 2 * ph1; ++pp) {
        const int ph = pp >> 1;
        if ((pp & 1) && !((ph > 0 && ((PROBE_DUP >> ((ph - 1) % 15)) & 1)) || (ph == 0 && (PROBE_DUP >> 20)))) continue;
        run_phase(p, ph, blockIdx.x, gridDim.x, smem);
        xcd_barrier(xb);
    }
#else
    for (int ph = ph0; ph < ph1; ++ph) {
        run_phase(p, ph, blockIdx.x, gridDim.x, smem);
        if (ph + 1 < ph1) xcd_barrier(xb);
    }
#endif
#else
    for (int ph = ph0; ph < ph1; ++ph) run_phase(p, ph, blockIdx.x, gridDim.x, smem);
#endif
}

extern "C" void kernel_launch(void* const* d_in, const int* in_sizes, int n_in, void* d_out, int out_size, void* d_ws, size_t ws_size, hipStream_t stream) {
    static int grid_blocks = 0;
    if (!grid_blocks) {
        int dev = 0, cus = 0, per_cu = 0;
        hipGetDevice(&dev);
        hipDeviceGetAttribute(&cus, hipDeviceAttributeMultiprocessorCount, dev);
        hipFuncSetAttribute((const void*)fwd_kernel, hipFuncAttributeMaxDynamicSharedMemorySize, LDS_BYTES);
        hipOccupancyMaxActiveBlocksPerMultiprocessor(&per_cu, fwd_kernel, NTHR, LDS_BYTES);
        if (per_cu < 1) per_cu = 1;
        if (per_cu > 1) per_cu = 1;
        grid_blocks = cus * per_cu;
    }
    if (ws_size < WS_TOTAL) { fprintf(stderr, "workspace too small: %zu < %zu\n", ws_size, (size_t)WS_TOTAL); return; }
    Params p{};
    for (int i = 0; i < 33; ++i) p.in[i] = (const float*)d_in[i];
    p.out = (float*)d_out;
    p.ws = (char*)d_ws;
#if MEGA
    hipMemsetAsync((char*)d_ws + B_BAR, 0, XCD_BAR_WORDS * 4, stream);
    int ph0 = 0, ph1 = NPHASE;
    void* args[] = {&p, &ph0, &ph1};
    hipError_t e = hipLaunchCooperativeKernel((const void*)fwd_kernel, dim3(grid_blocks), dim3(NTHR), args, LDS_BYTES, stream);
    if (e != hipSuccess) fprintf(stderr, "cooperative launch failed: %s (grid %d)\n", hipGetErrorString(e), grid_blocks);
#else
    for (int ph = 0; ph < NPHASE; ++ph) hipLaunchKernelGGL(fwd_kernel, dim3(grid_blocks), dim3(NTHR), LDS_BYTES, stream, p, ph, ph + 1);
#endif
}
```

```cpp
#include <hip/hip_runtime.h>
#include <hip/hip_cooperative_groups.h>
#include <cstdio>
#include <cstdint>
namespace cg = cooperative_groups;

#ifndef MEGA
#define MEGA 1
#endif

typedef unsigned short bf16_t;
typedef short bf16x8 __attribute__((ext_vector_type(8)));
typedef short s16x4 __attribute__((ext_vector_type(4)));
typedef float f32x4 __attribute__((ext_vector_type(4)));
typedef unsigned u32x4 __attribute__((ext_vector_type(4)));
typedef unsigned u32x2 __attribute__((ext_vector_type(2)));

#define DI __device__ __forceinline__
#define LAS __attribute__((address_space(3)))

constexpr int DM = 1024, NP = 16384, NS = 256, MT = NP + NS;
constexpr int SEQ = 2048, TS = 32, PAST = 1024, TKS = PAST + TS;
constexpr int KALL = NP + 8 * TKS;
constexpr int DFF = 2816;
constexpr float EPS = 1e-6f;
constexpr float LOG2E = 1.4426950408889634f;

constexpr size_t O_Y = 0;
constexpr size_t O_AKP = (size_t)MT * 1024;
constexpr size_t O_AVP = O_AKP + 8388608;
constexpr size_t O_BCKVP = O_AVP + 8388608;
constexpr size_t O_BKRP = O_BCKVP + 4194304;
constexpr size_t O_CKP = O_BKRP + 1048576;
constexpr size_t O_CVP = O_CKP + 8388608;
constexpr size_t O_CLFP = O_CVP + 8388608;
constexpr size_t O_AKS = O_CLFP + 131072;
constexpr size_t O_AVS = O_AKS + 131072;
constexpr size_t O_BCKVS = O_AVS + 131072;
constexpr size_t O_BKRS = O_BCKVS + 65536;
constexpr size_t O_CKS = O_BKRS + 16384;
constexpr size_t O_CVS = O_CKS + 131072;
constexpr size_t O_CLFS = O_CVS + 131072;

constexpr size_t al256(size_t x) { return (x + 255) & ~(size_t)255; }
constexpr size_t W_GU1 = 0;
constexpr size_t W_DN1 = W_GU1 + (size_t)5632 * 1024 * 2;
constexpr size_t W_IN = W_DN1 + (size_t)1024 * 2816 * 2;
constexpr size_t W_UQ = W_IN + (size_t)2048 * 1024 * 2;
constexpr size_t W_UKV = W_UQ + (size_t)768 * 256 * 2;
constexpr size_t W_OUT = W_UKV + (size_t)1024 * 128 * 2;
constexpr size_t W_GU2 = W_OUT + (size_t)1024 * 1024 * 2;
constexpr size_t W_DN2 = W_GU2 + (size_t)5632 * 1024 * 2;
constexpr size_t W_PG = W_DN2 + (size_t)1024 * 2816 * 2;
constexpr size_t W_PP = W_PG + (size_t)1024 * 1024 * 2;
constexpr size_t W_PBF = W_PP + (size_t)1024 * 256 * 2;
constexpr size_t W_END = W_PBF + (size_t)MT * 256 * 2;
constexpr size_t B_XN = al256(W_END);
constexpr size_t B_ACT = B_XN + (size_t)MT * 1024 * 2;
constexpr size_t B_Y = B_ACT + (size_t)MT * 2816 * 2;
constexpr size_t B_X1 = B_Y + (size_t)MT * 1024 * 4;
constexpr size_t B_QA = B_ACT;
constexpr size_t B_QC = B_QA + (size_t)MT * 256 * 2;
constexpr size_t B_QB = B_QC + (size_t)MT * 256 * 2;
constexpr size_t B_KA = B_QB + (size_t)MT * 768 * 2;
constexpr size_t B_VA = B_KA + (size_t)KALL * 256 * 2;
constexpr size_t B_KC = B_VA + (size_t)KALL * 256 * 2;
constexpr size_t B_VC = B_KC + (size_t)KALL * 256 * 2;
constexpr size_t B_ACT_END = B_VC + (size_t)KALL * 256 * 2;
static_assert(B_ACT_END <= B_Y, "mixer overlay exceeds act region");
constexpr size_t B_SMALL = B_Y;
constexpr size_t B_CQN = B_SMALL + (size_t)MT * 512 * 4;
static_assert(B_CQN + (size_t)MT * 256 * 2 <= B_X1, "Y overlay");
constexpr size_t B_CKVN = B_X1;
constexpr size_t B_KR = B_CKVN + (size_t)KALL * 128 * 2;
constexpr size_t B_F = B_KR + (size_t)KALL * 32 * 2;
constexpr size_t B_KVB = al256(B_F + (size_t)KALL * 4 * 4);
constexpr size_t B_YS = al256(B_KVB + (size_t)KALL * 1024 * 2);
constexpr size_t B_BAR = al256(B_YS + (size_t)11 * NS * 1024 * 4);
constexpr size_t WS_TOTAL = B_BAR + 3456 * 4;

constexpr int LDS_BYTES = 147456;
constexpr int NTHR = 512, NWAVE = 8;

struct Params {
    const float* in[33];
    float* out;
    char* ws;
};

typedef __bf16 bf2_t __attribute__((ext_vector_type(2)));
typedef float f32x2 __attribute__((ext_vector_type(2)));
DI unsigned pk2(float lo, float hi) { const f32x2 v = {lo, hi}; return __builtin_bit_cast(unsigned, __builtin_convertvector(v, bf2_t)); }
DI bf16_t f2bf(float x) { return (bf16_t)(pk2(x, 0.f) & 0xffffu); }
DI float wave_sum(float v) {
#pragma unroll
    for (int o = 32; o >= 1; o >>= 1) v += __shfl_xor(v, o);
    return v;
}
DI void swap16(float x, float& a, float& b) { const auto r = __builtin_amdgcn_permlane16_swap(__float_as_uint(x), __float_as_uint(x), false, false); a = __uint_as_float(r[0]); b = __uint_as_float(r[1]); }
DI void swap32(float x, float& a, float& b) { const auto r = __builtin_amdgcn_permlane32_swap(__float_as_uint(x), __float_as_uint(x), false, false); a = __uint_as_float(r[0]); b = __uint_as_float(r[1]); }
DI float log_sigmoid_f(float x) { return fminf(x, 0.f) - log1pf(expf(-fabsf(x))); }
DI void rope_cs(int pos, int i, float& c, float& s) {
    float inv = exp2f(-(float)i * (13.287712379549449f / 16.0f));
    float rev = (float)pos * inv * 0.15915494309189535f;
    rev -= rintf(rev);
    c = __builtin_amdgcn_cosf(rev);
    s = __builtin_amdgcn_sinf(rev);
}
DI int krow_of(int r) { return r < NP ? r : NP + ((r - NP) >> 5) * TKS + PAST + ((r - NP) & 31); }

DI int wmap(int mode, int n) {
    if (mode == 1) { return n < DFF ? ((n >> 4) * 32 + (n & 15)) : (((n - DFF) >> 4) * 32 + 16 + ((n - DFF) & 15)); }
    if (mode == 2) {
        if (n < 768) return n;
        if (n < 1024) return 1536 + (n - 768);
        if (n < 1152) return 1792 + (n - 1024);
        if (n < 1184) return 1920 + (n - 1152);
        if (n < 1952) return 768 + (n - 1184);
        return n;
    }
    return n;
}

DI void wtile(const float* __restrict__ src, bf16_t* __restrict__ dst, int K, int Nsrc, int mode, int tk, int tn, float* tile, const int tid) {
    const int wave = tid >> 6, lane = tid & 63;
    __syncthreads();
    float4 v[8];
    const int n4 = tn * 256 + lane * 4;
#pragma unroll
    for (int i = 0; i < 8; ++i) {
        const int k = tk * 64 + wave * 8 + i;
        v[i] = make_float4(0.f, 0.f, 0.f, 0.f);
        if (n4 < Nsrc) v[i] = *(const float4*)(src + (size_t)k * Nsrc + n4);
    }
#pragma unroll
    for (int i = 0; i < 8; ++i) *(float4*)(tile + (wave * 8 + i) * 260 + lane * 4) = v[i];
    __syncthreads();
    const int nl = tid & 255, n = tn * 256 + nl;
    if (n < Nsrc) {
        const int dr = wmap(mode, n);
#pragma unroll
        for (int i = 0; i < 4; ++i) {
            const int kc = ((tid >> 8) + 2 * i) * 8;
            const float* t = tile + kc * 260 + nl;
            u32x4 w;
            w.x = pk2(t[0], t[260]); w.y = pk2(t[2 * 260], t[3 * 260]); w.z = pk2(t[4 * 260], t[5 * 260]); w.w = pk2(t[6 * 260], t[7 * 260]);
            *(u32x4*)(dst + (size_t)dr * K + tk * 64 + kc) = w;
        }
    }
}

DI void prep_phase(const Params& p, int l, int bid, int nb, char* smem, const int tid) {
    float* tile = (float*)smem;
    for (int t = bid; t < 1348; t += nb) {
        const float* src; bf16_t* dst; int K, N, mode, base;
        if (t < 352) { src = p.in[13] + (size_t)l * 1024 * 5632; dst = (bf16_t*)(p.ws + W_GU1); K = 1024; N = 5632; mode = 1; base = 0; }
        else if (t < 528) { src = p.in[14] + (size_t)l * 2816 * 1024; dst = (bf16_t*)(p.ws + W_DN1); K = 2816; N = 1024; mode = 0; base = 352; }
        else if (t < 656) { src = p.in[17] + (size_t)l * 1024 * 1956; dst = (bf16_t*)(p.ws + W_IN); K = 1024; N = 1956; mode = 2; base = 528; }
        else if (t < 668) { src = p.in[21] + (size_t)l * 256 * 768; dst = (bf16_t*)(p.ws + W_UQ); K = 256; N = 768; mode = 0; base = 656; }
        else if (t < 676) { src = p.in[22] + (size_t)l * 128 * 1024; dst = (bf16_t*)(p.ws + W_UKV); K = 128; N = 1024; mode = 0; base = 668; }
        else if (t < 740) { src = p.in[24] + (size_t)l * 1024 * 1024; dst = (bf16_t*)(p.ws + W_OUT); K = 1024; N = 1024; mode = 0; base = 676; }
        else if (t < 1092) { src = p.in[27] + (size_t)l * 1024 * 5632; dst = (bf16_t*)(p.ws + W_GU2); K = 1024; N = 5632; mode = 1; base = 740; }
        else if (t < 1268) { src = p.in[28] + (size_t)l * 2816 * 1024; dst = (bf16_t*)(p.ws + W_DN2); K = 2816; N = 1024; mode = 0; base = 1092; }
        else if (t < 1332) { src = p.in[30] + (size_t)l * 1024 * 1024; dst = (bf16_t*)(p.ws + W_PG); K = 1024; N = 1024; mode = 0; base = 1268; }
        else { src = p.in[31] + (size_t)l * 256 * 1024; dst = (bf16_t*)(p.ws + W_PP); K = 256; N = 1024; mode = 0; base = 1332; }
        const int lt = t - base, nkt = K / 64;
        wtile(src, dst, K, N, mode, lt % nkt, lt / nkt, tile, tid);
    }
    {
        bf16_t* win = (bf16_t*)(p.ws + W_IN);
        const int total = (2048 - 1956) * 1024 / 8;
        for (int i = bid * NTHR + tid; i < total; i += nb * NTHR) {
            u32x4 z = {0u, 0u, 0u, 0u};
            *(u32x4*)(win + (size_t)1956 * 1024 + (size_t)i * 8) = z;
        }
    }
    {
        bf16_t* pbf = (bf16_t*)(p.ws + W_PBF);
        const int total = MT * 256 / 8;
        for (int i = bid * NTHR + tid; i < total; i += nb * NTHR) {
            const size_t e = (size_t)i * 8;
            const float* s = (e < (size_t)NP * 256) ? (p.in[2] + (size_t)l * NP * 256 + e) : (p.in[3] + (size_t)l * NS * 256 + (e - (size_t)NP * 256));
            const float4 a = *(const float4*)s, b = *(const float4*)(s + 4);
            u32x4 w; w.x = pk2(a.x, a.y); w.y = pk2(a.z, a.w); w.z = pk2(b.x, b.y); w.w = pk2(b.z, b.w);
            *(u32x4*)(pbf + e) = w;
        }
    }
}

DI void rowpass(const Params& p, bool init, float scale, const float* __restrict__ gpost, const float* __restrict__ gnext, int nparts, int bid, int nb, const int tid) {
    const int wave = __builtin_amdgcn_readfirstlane(tid >> 6), lane = tid & 63;
    float* H = p.out + O_Y;
    const bf16_t* YB = (const bf16_t*)(p.ws + B_Y);
    const float* YS = (const float*)(p.ws + B_YS);
    bf16_t* XN = (bf16_t*)(p.ws + B_XN);
    for (int row = bid * NWAVE + wave; row < MT; row += nb * NWAVE) {
        float4 h[4];
        if (init) {
            const float* x = row < NP ? p.in[0] + (size_t)row * DM : p.in[1] + (size_t)(row - NP) * DM;
#pragma unroll
            for (int i = 0; i < 4; ++i) h[i] = *(const float4*)(x + i * 256 + lane * 4);

        } else {
            float4 y[4];
            float ss = 0.f;
#pragma unroll
            for (int i = 0; i < 4; ++i) h[i] = *(const float4*)(H + (size_t)row * DM + i * 256 + lane * 4);
            if (row < NP) {
                u32x2 yb[4];
#pragma unroll
                for (int i = 0; i < 4; ++i) yb[i] = *(const u32x2*)(YB + (size_t)row * DM + i * 256 + lane * 4);
#pragma unroll
                for (int i = 0; i < 4; ++i) y[i] = make_float4(__uint_as_float(yb[i].x << 16), __uint_as_float(yb[i].x & 0xffff0000u), __uint_as_float(yb[i].y << 16), __uint_as_float(yb[i].y & 0xffff0000u));
            } else {
#pragma unroll
                for (int i = 0; i < 4; ++i) y[i] = make_float4(0.f, 0.f, 0.f, 0.f);
                for (int pt = 0; pt < nparts; ++pt) {
#pragma unroll
                    for (int i = 0; i < 4; ++i) { const float4 u = *(const float4*)(YS + (size_t)pt * NS * DM + (size_t)(row - NP) * DM + i * 256 + lane * 4); y[i].x += u.x; y[i].y += u.y; y[i].z += u.z; y[i].w += u.w; }
                }
            }
#pragma unroll
            for (int i = 0; i < 4; ++i) ss += y[i].x * y[i].x + y[i].y * y[i].y + y[i].z * y[i].z + y[i].w * y[i].w;
            ss = wave_sum(ss);
            const float rs = rsqrtf(ss * (1.0f / DM) + EPS) * scale;
#pragma unroll
            for (int i = 0; i < 4; ++i) {
                const float4 g = *(const float4*)(gpost + i * 256 + lane * 4);
                h[i].x += y[i].x * rs * g.x; h[i].y += y[i].y * rs * g.y; h[i].z += y[i].z * rs * g.z; h[i].w += y[i].w * rs * g.w;
            }
        }
#pragma unroll
        for (int i = 0; i < 4; ++i) *(float4*)(H + (size_t)row * DM + i * 256 + lane * 4) = h[i];
        if (gnext) {
            float s2 = 0.f;
#pragma unroll
            for (int i = 0; i < 4; ++i) s2 += h[i].x * h[i].x + h[i].y * h[i].y + h[i].z * h[i].z + h[i].w * h[i].w;
            s2 = wave_sum(s2);
            const float r2 = rsqrtf(s2 * (1.0f / DM) + EPS);
#pragma unroll
            for (int i = 0; i < 4; ++i) {
                const float4 g = *(const float4*)(gnext + i * 256 + lane * 4);
                u32x2 w; w.x = pk2(h[i].x * r2 * g.x, h[i].y * r2 * g.y); w.y = pk2(h[i].z * r2 * g.z, h[i].w * r2 * g.w);
                *(u32x2*)(XN + (size_t)row * DM + i * 256 + lane * 4) = w;
            }
        }
    }
}

DI void onorm_pass(const Params& p, const float* __restrict__ ggrp, int bid, int nb, const int tid) {
    const int wave = __builtin_amdgcn_readfirstlane(tid >> 6), lane = tid & 63;
    const float* Y = (const float*)(p.ws + B_Y);
    bf16_t* XN = (bf16_t*)(p.ws + B_XN);
    for (int row = bid * NWAVE + wave; row < MT; row += nb * NWAVE) {
        float4 y[4]; float ss[4];
#pragma unroll
        for (int i = 0; i < 4; ++i) {
            y[i] = *(const float4*)(Y + (size_t)row * DM + i * 256 + lane * 4);
            ss[i] = wave_sum(y[i].x * y[i].x + y[i].y * y[i].y + y[i].z * y[i].z + y[i].w * y[i].w);
        }
        const float ra = rsqrtf(ss[0] * (1.0f / 256) + EPS), rb = rsqrtf((ss[1] + ss[2]) * (1.0f / 512) + EPS), rc = rsqrtf(ss[3] * (1.0f / 256) + EPS);
#pragma unroll
        for (int i = 0; i < 4; ++i) {
            const float r = i == 0 ? ra : (i == 3 ? rc : rb);
            const float4 g = *(const float4*)(ggrp + i * 256 + lane * 4);
            u32x2 w; w.x = pk2(y[i].x * r * g.x, y[i].y * r * g.y); w.y = pk2(y[i].z * r * g.z, y[i].w * r * g.w);
            *(u32x2*)(XN + (size_t)row * DM + i * 256 + lane * 4) = w;
        }
    }
}

DI void post_phase(const Params& p, int l, int bid, int nb, const int tid) {
    const int wave = __builtin_amdgcn_readfirstlane(tid >> 6), lane = tid & 63;
    const int gw = bid * NWAVE + wave, nw = nb * NWAVE;
    const float* SM = (const float*)(p.ws + B_SMALL);
    const float* bf_ = p.in[18] + l * 4;
    float* Fall = (float*)(p.ws + B_F);
    for (int sq = (wave == 0 ? bid : 64); sq < 64; sq += nb) {
        const int h = sq & 3, b = (sq >> 2) & 7;
        const float bfh = bf_[h];
        if (sq < 32) {
            float v[32]; float run = 0.f;
#pragma unroll
            for (int j = 0; j < 32; ++j) {
                const int e = lane * 32 + j;
                v[j] = log_sigmoid_f(SM[(size_t)(b * SEQ + e) * 512 + 416 + h] + bfh);
            }
#pragma unroll
            for (int j = 0; j < 32; ++j) { run += v[j]; v[j] = run; }
            float inc = run;
#pragma unroll
            for (int o = 1; o < 64; o <<= 1) { float t = __shfl_up(inc, o); if (lane >= o) inc += t; }
            const float ex = inc - run;
#pragma unroll
            for (int j = 0; j < 32; ++j) Fall[(size_t)(b * SEQ + lane * 32 + j) * 4 + h] = v[j] + ex;
        } else {
            const float* clf = p.in[10] + (size_t)(l * 8 + b) * PAST * 4;
            float v[17]; float run = 0.f;
#pragma unroll
            for (int j = 0; j < 17; ++j) {
                const int e = lane * 17 + j;
                float x = 0.f;
                if (e < PAST) x = clf[e * 4 + h];
                else if (e < TKS) x = log_sigmoid_f(SM[(size_t)(NP + b * TS + (e - PAST)) * 512 + 416 + h] + bfh);
                v[j] = x;
            }
#pragma unroll
            for (int j = 0; j < 17; ++j) { run += v[j]; v[j] = run; }
            float inc = run;
#pragma unroll
            for (int o = 1; o < 64; o <<= 1) { float t = __shfl_up(inc, o); if (lane >= o) inc += t; }
            const float ex = inc - run;
#pragma unroll
            for (int j = 0; j < 17; ++j) { const int e = lane * 17 + j; if (e < TKS) Fall[(size_t)(NP + b * TKS + e) * 4 + h] = v[j] + ex; }
        }
    }
    bf16_t* CQN = (bf16_t*)(p.ws + B_CQN);
    bf16_t* CKVN = (bf16_t*)(p.ws + B_CKVN);
    bf16_t* KR = (bf16_t*)(p.ws + B_KR);
    const float* gbq = p.in[19] + l * 256;
    const float* gbkv = p.in[20] + l * 128;
    for (int r = gw; r < MT; r += nw) {
        const float* s = SM + (size_t)r * 512;
        const int kr = krow_of(r);
        const bool samp = r >= NP;
        const size_t srow = samp ? (size_t)(l * NS + (r - NP)) : (size_t)(l * NP + r);
        {
            const float4 v = *(const float4*)(s + lane * 4);
            const float ss = wave_sum(v.x * v.x + v.y * v.y + v.z * v.z + v.w * v.w);
            const float rs = rsqrtf(ss * (1.0f / 256) + EPS);
            const float4 g = *(const float4*)(gbq + lane * 4);
            u32x2 w; w.x = pk2(v.x * rs * g.x, v.y * rs * g.y); w.y = pk2(v.z * rs * g.z, v.w * rs * g.w);
            *(u32x2*)(CQN + (size_t)r * 256 + lane * 4) = w;
        }
        {
            const float2 v = *(const float2*)(s + 256 + lane * 2);
            const float ss = wave_sum(v.x * v.x + v.y * v.y);
            const float rs = rsqrtf(ss * (1.0f / 128) + EPS);
            const float2 g = *(const float2*)(gbkv + lane * 2);
            const float a = v.x * rs * g.x, b = v.y * rs * g.y;
            float* so = p.out + (samp ? O_BCKVS : O_BCKVP) + srow * 128 + lane * 2;
            *(float2*)so = make_float2(a, b);
            *(unsigned*)(CKVN + (size_t)kr * 128 + lane * 2) = pk2(a, b);
        }
        if (lane < 16) {
            const float x1 = s[384 + lane], x2 = s[400 + lane];
            const int pos = samp ? PAST + ((r - NP) & 31) : (r & (SEQ - 1));
            float c, sn; rope_cs(pos, lane, c, sn);
            const float o1 = x1 * c - x2 * sn, o2 = x1 * sn + x2 * c;
            float* so = p.out + (samp ? O_BKRS : O_BKRP) + srow * 32;
            so[lane] = o1; so[lane + 16] = o2;
            KR[(size_t)kr * 32 + lane] = f2bf(o1); KR[(size_t)kr * 32 + 16 + lane] = f2bf(o2);
        }
        if (lane < 4) {
            const float lf = log_sigmoid_f(s[416 + lane] + bf_[lane]);
            p.out[(samp ? O_CLFS : O_CLFP) + srow * 4 + lane] = lf;
        }
    }
    bf16_t* KA = (bf16_t*)(p.ws + B_KA); bf16_t* VA = (bf16_t*)(p.ws + B_VA);
    bf16_t* KC = (bf16_t*)(p.ws + B_KC); bf16_t* VC = (bf16_t*)(p.ws + B_VC);
    for (int cr = gw; cr < 8 * PAST; cr += nw) {
        const int b = cr >> 10, t = cr & (PAST - 1);
        const size_t crow = (size_t)(l * 8 + b) * PAST + t;
        const size_t kr = (size_t)NP + b * TKS + t;
        {
            const float4 a = *(const float4*)(p.in[4] + crow * 256 + lane * 4);
            u32x2 w; w.x = pk2(a.x, a.y); w.y = pk2(a.z, a.w); *(u32x2*)(KA + kr * 256 + lane * 4) = w;
            const float4 b4 = *(const float4*)(p.in[5] + crow * 256 + lane * 4);
            w.x = pk2(b4.x, b4.y); w.y = pk2(b4.z, b4.w); *(u32x2*)(VA + kr * 256 + lane * 4) = w;
            const float4 c4 = *(const float4*)(p.in[8] + crow * 256 + lane * 4);
            w.x = pk2(c4.x, c4.y); w.y = pk2(c4.z, c4.w); *(u32x2*)(KC + kr * 256 + lane * 4) = w;
            const float4 d4 = *(const float4*)(p.in[9] + crow * 256 + lane * 4);
            w.x = pk2(d4.x, d4.y); w.y = pk2(d4.z, d4.w); *(u32x2*)(VC + kr * 256 + lane * 4) = w;
        }
        {
            const float2 v = *(const float2*)(p.in[6] + crow * 128 + lane * 2);
            *(unsigned*)(CKVN + kr * 128 + lane * 2) = pk2(v.x, v.y);
        }
        if (lane < 16) {
            const float2 v = *(const float2*)(p.in[7] + crow * 32 + lane * 2);
            *(unsigned*)(KR + kr * 32 + lane * 2) = pk2(v.x, v.y);
        }
    }
}

constexpr int LSTR = 72;
struct Ring { int st; int primed; };
DI void gemm_stream2(const bf16_t* __restrict__ A, int lda, const bf16_t* __restrict__ Bt, int ldb, int K, int m0, int n0,
                     const bool has_next, const bf16_t* __restrict__ An, int ldan, const bf16_t* __restrict__ Btn, int ldbn, int m0n, int n0n,
                     char* smem, f32x4 (&acc)[4][4], const int tid, Ring& rg) {
    LAS char* lds = (LAS char*)smem;
    const int wave = __builtin_amdgcn_readfirstlane(tid >> 6), lane = tid & 63, wm = wave >> 1, wn = wave & 1, r = lane & 15, q = lane >> 4;
    const int sc0 = ((lane & 7) ^ (lane >> 4)) * 8, sc1 = ((lane & 7) ^ (4 | (lane >> 4))) * 8;
    const bf16_t* ga = A + (size_t)(m0 + wave * 32 + (lane >> 3)) * lda;
    const bf16_t* gb = Bt + (size_t)(n0 + wave * 16 + (lane >> 3)) * ldb;
    const bf16_t* gan = An + (size_t)(m0n + wave * 32 + (lane >> 3)) * ldan;
    const bf16_t* gbn = Btn + (size_t)(n0n + wave * 16 + (lane >> 3)) * ldbn;
    const unsigned wa = (unsigned)wave * 4096u, wbb = 32768u + (unsigned)wave * 2048u;
#define STAGE(ST, KT) { _Pragma("unroll") for (int i = 0; i < 4; ++i) \
            __builtin_amdgcn_global_load_lds((const unsigned*)(ga + (size_t)i * 8 * lda + (KT) * 64 + ((i & 1) ? sc1 : sc0)), (LAS unsigned*)(lds + (ST) * 49152 + wa + i * 1024), 16, 0, 0); \
        _Pragma("unroll") for (int i = 0; i < 2; ++i) \
            __builtin_amdgcn_global_load_lds((const unsigned*)(gb + (size_t)i * 8 * ldb + (KT) * 64 + ((i & 1) ? sc1 : sc0)), (LAS unsigned*)(lds + (ST) * 49152 + wbb + i * 1024), 16, 0, 0); }
    const int sw = r >> 1;
    const unsigned fo0 = (unsigned)(r * 128 + ((q ^ sw) << 4)), fo1 = (unsigned)(r * 128 + (((q ^ sw) ^ 4) << 4));
    const unsigned aoff = (unsigned)(wm * 64) * 128u, boff = 32768u + (unsigned)(wn * 64) * 128u;
    const int nk = K / 64;
    const int grp = wave >> 2;
#define PIECE(S2, G) { if ((G) < 4) __builtin_amdgcn_global_load_lds((const unsigned*)(pa + (size_t)(G) * 8 * plda + (((G) & 1) ? sc1 : sc0)), (LAS unsigned*)(lds + (S2) * 49152 + wa + (G) * 1024), 16, 0, 0); \
        else __builtin_amdgcn_global_load_lds((const unsigned*)(pb + (size_t)((G) - 4) * 8 * pldb + (((G) & 1) ? sc1 : sc0)), (LAS unsigned*)(lds + (S2) * 49152 + wbb + ((G) - 4) * 1024), 16, 0, 0); }
#define BAR() { __builtin_amdgcn_sched_barrier(0); __builtin_amdgcn_s_barrier(); asm volatile("" ::: "memory"); __builtin_amdgcn_sched_barrier(0); }
    int st = rg.st;
    if (!rg.primed) {
        const int s1p = st == 2 ? 0 : st + 1;
        BAR();
        STAGE(st, 0);
        STAGE(s1p, 1);
        asm volatile("s_waitcnt vmcnt(6)" ::: "memory");
        BAR();
    }
    if (grp == 1) BAR();
    for (int kt = 0; kt < nk; ++kt) {
        const bool pf = (kt + 2 < nk) || has_next, more = (kt + 1 < nk) || has_next;
        const bf16_t* pa = (kt + 2 < nk) ? ga + (kt + 2) * 64 : gan + (kt + 2 - nk) * 64;
        const bf16_t* pb = (kt + 2 < nk) ? gb + (kt + 2) * 64 : gbn + (kt + 2 - nk) * 64;
        const int plda = (kt + 2 < nk) ? lda : ldan, pldb = (kt + 2 < nk) ? ldb : ldbn;
        const int s2 = st >= 1 ? st - 1 : 2;
        const LAS char* base = lds + st * 49152;
#pragma unroll
        for (int ks = 0; ks < 2; ++ks) {
            const unsigned fo = ks ? fo1 : fo0;
            bf16x8 af[4], bfr[4];
#pragma unroll
            for (int i = 0; i < 4; ++i) { af[i] = *(const LAS bf16x8*)(base + aoff + i * 2048 + fo); bfr[i] = *(const LAS bf16x8*)(base + boff + i * 2048 + fo); }
            if (ks == 1 && more) { if (pf) asm volatile("s_waitcnt vmcnt(3)" ::: "memory"); else asm volatile("s_waitcnt vmcnt(0)" ::: "memory"); }
            if (pf) { PIECE(s2, ks * 3 + 0); PIECE(s2, ks * 3 + 1); PIECE(s2, ks * 3 + 2); }
            asm volatile("s_waitcnt lgkmcnt(0)" ::: "memory");
            BAR();
            __builtin_amdgcn_s_setprio(1);
#pragma unroll
            for (int mi = 0; mi < 4; ++mi)
#pragma unroll
                for (int ni = 0; ni < 4; ++ni) acc[mi][ni] = __builtin_amdgcn_mfma_f32_16x16x32_bf16(bfr[ni], af[mi], acc[mi][ni], 0, 0, 0);
            __builtin_amdgcn_s_setprio(0);
            BAR();
        }
        st = st == 2 ? 0 : st + 1;
    }
    if (grp == 0) BAR();
    rg.st = st; rg.primed = has_next ? 1 : 0;
#undef PIECE
#undef BAR
#undef STAGE
}

DI void gemm_stream(const bf16_t* __restrict__ A, int lda, const bf16_t* __restrict__ Bt, int ldb, int K, int m0, int n0, const bool has_next, int m0n, int n0n,
                    char* smem, f32x4 (&acc)[4][4], const int tid, Ring& rg) {
    gemm_stream2(A, lda, Bt, ldb, K, m0, n0, has_next, A, lda, Bt, ldb, m0n, n0n, smem, acc, tid, rg);
}
DI void gemm_mainloop(const bf16_t* __restrict__ A, int lda, const bf16_t* __restrict__ Bt, int ldb, int K, int m0, int n0, char* smem, f32x4 (&acc)[4][4], const int tid) {
    Ring rg; rg.st = 0; rg.primed = 0;
    gemm_stream(A, lda, Bt, ldb, K, m0, n0, false, m0, n0, smem, acc, tid, rg);
}

struct TileIter {
    int L, end, step, ntm, ntn;
    DI void init(int ntm_, int ntn_, int bid, int nb) {
        ntm = ntm_; ntn = ntn_;
        const int nt = ntm * ntn;
        if ((nb & 7) == 0) { const int x = bid & 7, per = (nt + 7) >> 3; L = x * per + (bid >> 3); end = min((x + 1) * per, nt); step = nb >> 3; }
        else { L = bid; end = nt; step = nb; }
    }
    DI bool next(int& tm, int& tn) {
        if (L >= end) return false;
        const int gsz = 8 * ntn, grp = L / gsz, rem = L - grp * gsz, rows = min(8, ntm - grp * 8);
        tn = rem / rows; tm = grp * 8 + (rem - tn * rows);
        L += step; return true;
    }
};

DI void zero_acc(f32x4 (&acc)[4][4]) {
#pragma unroll
    for (int i = 0; i < 4; ++i)
#pragma unroll
        for (int j = 0; j < 4; ++j) acc[i][j] = (f32x4){0.f, 0.f, 0.f, 0.f};
}

DI void gemm_gu(const Params& p, size_t woff, int bid, int nb, char* smem, const int tid) {
    const bf16_t* A = (const bf16_t*)(p.ws + B_XN);
    const bf16_t* Bt = (const bf16_t*)(p.ws + woff);
    bf16_t* ACT = (bf16_t*)(p.ws + B_ACT);
    const int ntn = 44, ntiles = 130 * ntn;
    const int lane = tid & 63, wave = __builtin_amdgcn_readfirstlane(tid >> 6), wm = wave >> 1, wn = wave & 1, r = lane & 15, q = lane >> 4;
    TileIter ti; ti.init(65, ntn, bid, nb);
    int tm, tn, tm2 = 0, tn2 = 0;
    bool have = ti.next(tm, tn);
    Ring rg; rg.st = 0; rg.primed = 0;
    for (; have; tm = tm2, tn = tn2) {
        have = ti.next(tm2, tn2);
        const int m0 = tm * 256, n0 = tn * 128;
        f32x4 acc[4][4]; zero_acc(acc);
        gemm_stream(A, 1024, Bt, 1024, 1024, m0, n0, have, tm2 * 256, tn2 * 128, smem, acc, tid, rg);
        const int nb0 = n0 + wn * 64;
#pragma unroll
        for (int mi = 0; mi < 4; ++mi) {
            const int row = m0 + wm * 64 + mi * 16 + r;
#pragma unroll
            for (int pr = 0; pr < 2; ++pr) {
                const f32x4 g = acc[mi][2 * pr], u = acc[mi][2 * pr + 1];
                float o[4];
#pragma unroll
                for (int j = 0; j < 4; ++j) o[j] = g[j] * __builtin_amdgcn_rcpf(1.0f + __builtin_amdgcn_exp2f(-LOG2E * g[j])) * u[j];
                const int col = ((nb0 + pr * 32) >> 5) * 16 + q * 4;
                u32x2 w; w.x = pk2(o[0], o[1]); w.y = pk2(o[2], o[3]);
                *(u32x2*)(ACT + (size_t)row * DFF + col) = w;
            }
        }
    }
}

template <int MODE>
DI void epi_y(const Params& p, const f32x4 (&acc)[4][4], int m0, int n0, const int tid, const int part = 0) {
    bf16_t* Y = (bf16_t*)(p.ws + B_Y);
    float* YS = (float*)(p.ws + B_YS);
    const int lane = tid & 63, wave = __builtin_amdgcn_readfirstlane(tid >> 6), wm = wave >> 1, wn = wave & 1, r = lane & 15, q = lane >> 4;
#pragma unroll
    for (int mi = 0; mi < 4; ++mi) {
        const int row = m0 + wm * 64 + mi * 16 + r;
#pragma unroll
        for (int ni = 0; ni < 4; ++ni) {
            const int col = n0 + wn * 64 + ni * 16 + q * 4;
            if (MODE == 0) {
                u32x2 w; w.x = pk2(acc[mi][ni][0], acc[mi][ni][1]); w.y = pk2(acc[mi][ni][2], acc[mi][ni][3]);
                *(u32x2*)(Y + (size_t)row * DM + col) = w;
            } else if (MODE == 1) {
                *(f32x4*)(YS + (size_t)(row - NP) * DM + col) = acc[mi][ni];
            } else {
                *(f32x4*)(YS + (size_t)part * NS * DM + (size_t)(row - NP) * DM + col) = acc[mi][ni];
            }
        }
    }
}

DI void gemm_y(const Params& p, const bf16_t* A, int lda, size_t woff, int K, int kper, int bid, int nb, char* smem, const int tid) {
    const bf16_t* Bt = (const bf16_t*)(p.ws + woff);
    TileIter ti; ti.init(64, 8, bid, nb);
    int tm, tn, tm2 = 0, tn2 = 0;
    bool have = ti.next(tm, tn);
    Ring rg; rg.st = 0; rg.primed = 0;
    for (; have; tm = tm2, tn = tn2) {
        have = ti.next(tm2, tn2);
        const int m0 = tm * 256, n0 = tn * 128;
        f32x4 acc[4][4]; zero_acc(acc);
        gemm_stream(A, lda, Bt, K, K, m0, n0, have, tm2 * 256, tn2 * 128, smem, acc, tid, rg);
        epi_y<0>(p, acc, m0, n0, tid);
    }
    const int S = (K / 64) / kper;
    for (int u = bid; u < 8 * S; u += nb) {
        const int tile = u / S, part = u - tile * S, m0 = NP, n0 = tile * 128;
        f32x4 acc[4][4]; zero_acc(acc);
        gemm_mainloop(A + part * kper * 64, lda, Bt + part * kper * 64, K, kper * 64, m0, n0, smem, acc, tid);
        epi_y<2>(p, acc, m0, n0, tid, part);
    }
}

DI void gemm_ple(const Params& p, int bid, int nb, char* smem, const int tid) {
    const bf16_t* XN = (const bf16_t*)(p.ws + B_XN);
    const bf16_t* PB = (const bf16_t*)(p.ws + W_PBF);
    const bf16_t* WG = (const bf16_t*)(p.ws + W_PG);
    const bf16_t* WP = (const bf16_t*)(p.ws + W_PP);
    const int ntn = 8, ntiles = 130 * ntn;
    TileIter ti; ti.init(65, ntn, bid, nb);
    int tm, tn, tm2 = 0, tn2 = 0;
    bool have = ti.next(tm, tn);
    Ring rg; rg.st = 0; rg.primed = 0;
    for (; have; tm = tm2, tn = tn2) {
        have = ti.next(tm2, tn2);
        const int m0 = tm * 256, n0 = tn * 128;
        u32x2 gpk[4][4];
        {
            f32x4 gate[4][4]; zero_acc(gate);
            gemm_stream2(XN, 1024, WG, 1024, 1024, m0, n0, true, PB, 256, WP, 256, m0, n0, smem, gate, tid, rg);
#pragma unroll
            for (int i = 0; i < 4; ++i)
#pragma unroll
                for (int j = 0; j < 4; ++j) {
                    float g[4];
#pragma unroll
                    for (int e = 0; e < 4; ++e) g[e] = __builtin_amdgcn_rcpf(1.0f + __builtin_amdgcn_exp2f(-LOG2E * gate[i][j][e]));
                    gpk[i][j].x = pk2(g[0], g[1]); gpk[i][j].y = pk2(g[2], g[3]);
                }
        }
        f32x4 acc[4][4]; zero_acc(acc);
        gemm_stream2(PB, 256, WP, 256, 256, m0, n0, have, XN, 1024, WG, 1024, tm2 * 256, tn2 * 128, smem, acc, tid, rg);
#pragma unroll
        for (int i = 0; i < 4; ++i)
#pragma unroll
            for (int j = 0; j < 4; ++j) {
                acc[i][j][0] *= __uint_as_float(gpk[i][j].x << 16); acc[i][j][1] *= __uint_as_float(gpk[i][j].x & 0xffff0000u);
                acc[i][j][2] *= __uint_as_float(gpk[i][j].y << 16); acc[i][j][3] *= __uint_as_float(gpk[i][j].y & 0xffff0000u);
            }
        if (m0 < NP) epi_y<0>(p, acc, m0, n0, tid); else epi_y<1>(p, acc, m0, n0, tid);
    }
}

DI void gemm_in(const Params& p, int l, int bid, int nb, char* smem, const int tid) {
    const bf16_t* A = (const bf16_t*)(p.ws + B_XN);
    const bf16_t* Bt = (const bf16_t*)(p.ws + W_IN);
    const int ntn = 16, ntiles = 130 * ntn;
    const int lane = tid & 63, wave = __builtin_amdgcn_readfirstlane(tid >> 6), wm = wave >> 1, wn = wave & 1, r = lane & 15, q = lane >> 4;
    TileIter ti; ti.init(65, ntn, bid, nb);
    int tm, tn, tm2 = 0, tn2 = 0;
    bool have = ti.next(tm, tn);
    Ring rg; rg.st = 0; rg.primed = 0;
    for (; have; tm = tm2, tn = tn2) {
        have = ti.next(tm2, tn2);
        const int m0 = tm * 256, n0 = tn * 128;
        f32x4 acc[4][4]; zero_acc(acc);
        gemm_stream(A, 1024, Bt, 1024, 1024, m0, n0, have, tm2 * 256, tn2 * 128, smem, acc, tid, rg);
        const int nb0 = n0 + wn * 64;
        const int seg = nb0 >> 8;
        const int cin = nb0 & 255;
        if (seg == 0 || seg == 3) {
            bf16_t* Q = (bf16_t*)(p.ws + (seg == 0 ? B_QA : B_QC));
#pragma unroll
            for (int mi = 0; mi < 4; ++mi) {
                const int row = m0 + wm * 64 + mi * 16 + r;
#pragma unroll
                for (int ni = 0; ni < 4; ++ni) {
                    u32x2 w; w.x = pk2(acc[mi][ni][0], acc[mi][ni][1]); w.y = pk2(acc[mi][ni][2], acc[mi][ni][3]);
                    *(u32x2*)(Q + (size_t)row * 256 + cin + ni * 16 + q * 4) = w;
                }
            }
        } else if (seg < 6) {
            const size_t boff = seg == 1 ? B_KA : seg == 2 ? B_VA : seg == 4 ? B_KC : B_VC;
            const bool samp = m0 >= NP;
            const size_t ooff = samp ? (seg == 1 ? O_AKS : seg == 2 ? O_AVS : seg == 4 ? O_CKS : O_CVS) : (seg == 1 ? O_AKP : seg == 2 ? O_AVP : seg == 4 ? O_CKP : O_CVP);
            bf16_t* KV = (bf16_t*)(p.ws + boff);
#pragma unroll
            for (int mi = 0; mi < 4; ++mi) {
                const int row = m0 + wm * 64 + mi * 16 + r;
                const size_t srow = samp ? (size_t)(l * NS + (row - NP)) : (size_t)(l * NP + row);
                const size_t kr = (size_t)krow_of(row);
#pragma unroll
                for (int ni = 0; ni < 4; ++ni) {
                    const int c = cin + ni * 16 + q * 4;
                    *(f32x4*)(p.out + ooff + srow * 256 + c) = acc[mi][ni];
                    u32x2 w; w.x = pk2(acc[mi][ni][0], acc[mi][ni][1]); w.y = pk2(acc[mi][ni][2], acc[mi][ni][3]);
                    *(u32x2*)(KV + kr * 256 + c) = w;
                }
            }
        } else {
            float* SM = (float*)(p.ws + B_SMALL);
#pragma unroll
            for (int mi = 0; mi < 4; ++mi) {
                const int row = m0 + wm * 64 + mi * 16 + r;
#pragma unroll
                for (int ni = 0; ni < 4; ++ni) *(f32x4*)(SM + (size_t)row * 512 + (nb0 - 1536) + ni * 16 + q * 4) = acc[mi][ni];
            }
        }
    }
}

DI void gemm_uqkv(const Params& p, int bid, int nb, char* smem, const int tid) {
    const int lane = tid & 63, wave = __builtin_amdgcn_readfirstlane(tid >> 6), wm = wave >> 1, wn = wave & 1, r = lane & 15, q = lane >> 4;
    const int nuq = 65 * 6, nukv = (KALL / 256) * 8;
    const bf16_t* CQN = (const bf16_t*)(p.ws + B_CQN); const bf16_t* WUQ = (const bf16_t*)(p.ws + W_UQ);
    const bf16_t* CKV = (const bf16_t*)(p.ws + B_CKVN); const bf16_t* WUKV = (const bf16_t*)(p.ws + W_UKV);
    Ring rg; rg.st = 0; rg.primed = 0;
    const int total = nuq + nukv;
    int t0, tend, tstep;
    if ((nb & 7) == 0) { const int x = bid & 7, per = (total + 7) >> 3; t0 = x * per + (bid >> 3); tend = min((x + 1) * per, total); tstep = nb >> 3; }
    else { t0 = bid; tend = total; tstep = nb; }
    for (int t = t0; t < tend; t += tstep) {
        f32x4 acc[4][4]; zero_acc(acc);
        const int t2 = t + tstep;
        const bool hn = t2 < tend, nuqn = t2 < nuq;
        const int u2 = nuqn ? t2 : t2 - nuq;
        const int m0n = (nuqn ? u2 / 6 : u2 / 8) * 256, n0n = (nuqn ? u2 % 6 : u2 % 8) * 128;
        const bf16_t* An = nuqn ? CQN : CKV; const bf16_t* Btn = nuqn ? WUQ : WUKV; const int ldn = nuqn ? 256 : 128;
        if (t < nuq) {
            const int tm = t / 6, tn = t % 6, m0 = tm * 256, n0 = tn * 128;
            gemm_stream2(CQN, 256, WUQ, 256, 256, m0, n0, hn, An, ldn, Btn, ldn, m0n, n0n, smem, acc, tid, rg);
            bf16_t* QB = (bf16_t*)(p.ws + B_QB);
            const int nb0 = n0 + wn * 64, f0 = nb0 >> 4;
#pragma unroll
            for (int mi = 0; mi < 4; ++mi) {
                const int row = m0 + wm * 64 + mi * 16 + r;
                const int pos = row < NP ? (row & (SEQ - 1)) : PAST + ((row - NP) & 31);
#pragma unroll
                for (int pr = 0; pr < 2; ++pr) {
                    f32x4 a = acc[mi][2 * pr], b = acc[mi][2 * pr + 1];
                    if ((f0 + 2 * pr) % 6 == 4) {
#pragma unroll
                        for (int j = 0; j < 4; ++j) {
                            float c, s; rope_cs(pos, q * 4 + j, c, s);
                            const float x1 = a[j], x2 = b[j];
                            a[j] = x1 * c - x2 * s; b[j] = x1 * s + x2 * c;
                        }
                    }
                    u32x2 w; w.x = pk2(a[0], a[1]); w.y = pk2(a[2], a[3]);
                    *(u32x2*)(QB + (size_t)row * 768 + nb0 + pr * 32 + q * 4) = w;
                    w.x = pk2(b[0], b[1]); w.y = pk2(b[2], b[3]);
                    *(u32x2*)(QB + (size_t)row * 768 + nb0 + pr * 32 + 16 + q * 4) = w;
                }
            }
        } else {
            const int t2 = t - nuq, tm = t2 / 8, tn = t2 % 8, m0 = tm * 256, n0 = tn * 128;
            gemm_stream2(CKV, 128, WUKV, 128, 128, m0, n0, hn, An, ldn, Btn, ldn, m0n, n0n, smem, acc, tid, rg);
            bf16_t* KVB = (bf16_t*)(p.ws + B_KVB);
#pragma unroll
            for (int mi = 0; mi < 4; ++mi) {
                const int row = m0 + wm * 64 + mi * 16 + r;
#pragma unroll
                for (int ni = 0; ni < 4; ++ni) {
                    u32x2 w; w.x = pk2(acc[mi][ni][0], acc[mi][ni][1]); w.y = pk2(acc[mi][ni][2], acc[mi][ni][3]);
                    *(u32x2*)(KVB + (size_t)row * 1024 + n0 + wn * 64 + ni * 16 + q * 4) = w;
                }
            }
        }
    }
}

constexpr int KSTR = 104;
constexpr int VSTR = 68;
struct AttnItem {
    const bf16_t* Q; int ldq;
    const bf16_t* K; int ldk;
    const bf16_t* KR;
    const bf16_t* V; int ldv;
    const float* F;
    float* O;
    int nq, qpos0, Tk, ntiles;
};

template <int MODE, bool MASKED>
DI void attn_scores(const f32x4 (&s)[4], float (&pw)[4][4], const int kt, const int q, const int qpos, const int Tk, const LAS float* sF, const float sc,
                    float& m, float& lsum, float& R, f32x4 (&o)[4]) {
    if (MODE == 0) {
        float e[4][4], hq[4], T[4];
#pragma unroll
        for (int st = 0; st < 4; ++st) {
            float lv[4];
#pragma unroll
            for (int j = 0; j < 4; ++j) {
                const int key = kt * 64 + st * 16 + q * 4 + j;
                const float z = s[st][j] * sc;
                const bool valid = !MASKED || key < qpos;
                lv[j] = valid ? -(fmaxf(z, 0.f) + __logf(1.0f + __expf(-fabsf(z)))) : 0.f;
                pw[st][j] = valid ? z + lv[j] : -1e30f;
            }
            e[st][3] = 0.f; e[st][2] = lv[3]; e[st][1] = lv[3] + lv[2]; e[st][0] = lv[3] + lv[2] + lv[1];
            const float tot = e[st][0] + lv[0];
            float a16, b16, a32, b32;
            swap16(tot, a16, b16);
            const float pr = a16 + b16;
            swap32(pr, a32, b32);
            T[st] = a32 + b32;
            hq[st] = ((q & 1) == 0 ? b16 : 0.f) + ((q & 2) == 0 ? b32 : 0.f);
        }
        float after = 0.f;
#pragma unroll
        for (int st = 3; st >= 0; --st) {
#pragma unroll
            for (int j = 0; j < 4; ++j) {
                const float arg = pw[st][j] + (R + after + hq[st] + e[st][j]);
                pw[st][j] = (!MASKED || pw[st][j] > -1e29f) ? __expf(arg) : 0.f;
            }
            after += T[st];
        }
        R += after;
    } else {
        float mx = -1e30f;
#pragma unroll
        for (int st = 0; st < 4; ++st) {
            f32x4 fv = (f32x4){0.f, 0.f, 0.f, 0.f};
            if (MODE == 2) fv = *(const LAS f32x4*)(sF + st * 16 + q * 4);
#pragma unroll
            for (int j = 0; j < 4; ++j) {
                const int key = kt * 64 + st * 16 + q * 4 + j;
                const bool valid = !MASKED || ((key < Tk) && (MODE == 1 ? ((key >> 6) <= (qpos >> 6)) : (key <= qpos)));
                const float z = s[st][j] * (sc * LOG2E) - fv[j];
                pw[st][j] = valid ? z : -1e30f;
                mx = fmaxf(mx, pw[st][j]);
            }
        }
        { float a, b; swap16(mx, a, b); mx = fmaxf(a, b); swap32(mx, a, b); mx = fmaxf(a, b); }
        const float mn = fmaxf(m, mx);
        const float alpha = __builtin_amdgcn_exp2f(m - mn);
        m = mn;
        float ps = 0.f;
#pragma unroll
        for (int st = 0; st < 4; ++st)
#pragma unroll
            for (int j = 0; j < 4; ++j) {
                const float pv = (!MASKED || pw[st][j] > -1e29f) ? __builtin_amdgcn_exp2f(pw[st][j] - mn) : 0.f;
                pw[st][j] = pv; ps += pv;
            }
        lsum = lsum * alpha + ps;
#pragma unroll
        for (int i = 0; i < 4; ++i) o[i] = o[i] * alpha;
    }
}

template <int MODE>
DI void attn_item(const AttnItem& a, char* smem, const int tid) {
    constexpr int DQK = MODE == 1 ? 96 : 64, NKS = DQK / 32;
    constexpr unsigned KOFF = 0, VOFF = 8192, KROFF = 16384, FOFF = 20480, ASTG = 21504;
    LAS char* lds = (LAS char*)smem;
    const int wave = __builtin_amdgcn_readfirstlane(tid >> 6), lane = tid & 63, r = lane & 15, q = lane >> 4;
    const int qi = wave * 16 + r;
    const int qic = qi < a.nq ? qi : a.nq - 1;
    const int qpos = a.qpos0 + qic;
    bf16x8 qf[NKS];
#pragma unroll
    for (int ks = 0; ks < NKS; ++ks) qf[ks] = *(const bf16x8*)(a.Q + (size_t)qic * a.ldq + ks * 32 + q * 8);
    f32x4 o[4];
#pragma unroll
    for (int i = 0; i < 4; ++i) o[i] = (f32x4){0.f, 0.f, 0.f, 0.f};
    float m = -1e30f, lsum = 0.f, R = 0.f;
    const float sc = MODE == 1 ? 0.10206207261596575f : 0.125f;
    const int srow8 = lane >> 3;
    const int sf = (((srow8 >> 1) & 1) << 2) | (((srow8 >> 2) & 1) << 1);
    const int schunk = (lane & 7) ^ sf;
    const int kchunk = (lane & 7) ^ (((wave & 1) << 2) | (srow8 >> 1));
    const unsigned wb = (unsigned)wave * 1024u;
#define ASTAGE(ST, KT) { \
        { int key = (KT) * 64 + wave * 8 + srow8; key = key < a.Tk ? key : a.Tk - 1; \
            __builtin_amdgcn_global_load_lds((const unsigned*)(a.K + (size_t)key * a.ldk + kchunk * 8), (LAS unsigned*)(lds + (ST) * ASTG + KOFF + wb), 16, 0, 0); \
            __builtin_amdgcn_global_load_lds((const unsigned*)(a.V + (size_t)key * a.ldv + schunk * 8), (LAS unsigned*)(lds + (ST) * ASTG + VOFF + wb), 16, 0, 0); } \
        if (MODE == 1 && wave < 4) { int key = (KT) * 64 + wave * 16 + (lane >> 2); key = key < a.Tk ? key : a.Tk - 1; \
            __builtin_amdgcn_global_load_lds((const unsigned*)(a.KR + (size_t)key * 32 + ((lane & 3) ^ (((lane >> 5) & 1) << 1)) * 8), (LAS unsigned*)(lds + (ST) * ASTG + KROFF + (unsigned)wave * 1024u), 16, 0, 0); } }
    const int fr_ = (((r >> 1) & 1) << 2) | (((r >> 2) & 1) << 1);
    const unsigned ko0 = (unsigned)(r * 128 + ((q ^ (r >> 1)) << 4)), ko1 = (unsigned)(r * 128 + (((4 + q) ^ (r >> 1)) << 4)), ko2 = (unsigned)(r * 64 + ((q ^ (((r >> 3) & 1) << 1)) << 4));
    const int qq = r >> 2, pp = r & 3;
    const int vf_ = (((qq >> 1) & 1) << 2) | ((q & 1) << 1);
    const unsigned vbase = (unsigned)((q * 4 + qq) * 128 + (pp & 1) * 8);
    __syncthreads();
    {
        const int kt0 = MODE == 0 ? (a.ntiles - 1) : 0;
        ASTAGE(0, kt0);
        if (MODE == 2 && tid < 64) { int key = kt0 * 64 + tid; key = key < a.Tk ? key : a.Tk - 1; *(LAS float*)(lds + FOFF + tid * 4) = a.F[(size_t)key * 4] * LOG2E; }
    }
    for (int it = 0; it < a.ntiles; ++it) {
        const int kt = MODE == 0 ? (a.ntiles - 1 - it) : it;
        const int st_ = it & 1;
        asm volatile("s_waitcnt vmcnt(0)" ::: "memory");
        __syncthreads();
        if (MODE == 0 && it > 0) {
            const LAS unsigned* fl = (const LAS unsigned*)(lds + 2 * ASTG + ((it - 1) & 1) * 64);
            unsigned all = 1u;
#pragma unroll
            for (int w = 0; w < NWAVE; ++w) all &= fl[w];
            if (all) break;
        }
        float fnext = 0.f;
        if (it + 1 < a.ntiles) {
            const int ktn = MODE == 0 ? (kt - 1) : (kt + 1);
            ASTAGE(st_ ^ 1, ktn);
            if (MODE == 2 && tid < 64) { int key = ktn * 64 + tid; key = key < a.Tk ? key : a.Tk - 1; fnext = a.F[(size_t)key * 4] * LOG2E; }
        }
        const LAS char* sK = lds + st_ * ASTG + KOFF;
        const LAS char* sV = lds + st_ * ASTG + VOFF;
        const LAS char* sKR = lds + st_ * ASTG + KROFF;
        const LAS float* sF = (const LAS float*)(lds + st_ * ASTG + FOFF);
        const int qhi = a.qpos0 + min(wave * 16 + 15, a.nq - 1);
        const bool none = (wave * 16 >= a.nq) || (MODE == 0 ? (kt * 64 >= qhi) : MODE == 1 ? (kt > (qhi >> 6)) : (kt * 64 > qhi));
        if (!none) {
        f32x4 s[4];
#pragma unroll
        for (int st = 0; st < 4; ++st) {
            s[st] = (f32x4){0.f, 0.f, 0.f, 0.f};
            s[st] = __builtin_amdgcn_mfma_f32_16x16x32_bf16(*(const LAS bf16x8*)(sK + st * 2048 + ko0), qf[0], s[st], 0, 0, 0);
            s[st] = __builtin_amdgcn_mfma_f32_16x16x32_bf16(*(const LAS bf16x8*)(sK + st * 2048 + ko1), qf[1], s[st], 0, 0, 0);
            if (MODE == 1) s[st] = __builtin_amdgcn_mfma_f32_16x16x32_bf16(*(const LAS bf16x8*)(sKR + st * 1024 + ko2), qf[NKS - 1], s[st], 0, 0, 0);
        }
        float pw[4][4];
        bool full;
        {
            const int qlo = a.qpos0 + min(wave * 16, a.nq - 1), klast = kt * 64 + 63;
            full = MODE == 0 ? (klast < qlo) : (klast < a.Tk && (MODE == 1 ? (kt <= (qlo >> 6)) : (klast <= qlo)));
        }
        if (full) attn_scores<MODE, false>(s, pw, kt, q, qpos, a.Tk, sF, sc, m, lsum, R, o);
        else attn_scores<MODE, true>(s, pw, kt, q, qpos, a.Tk, sF, sc, m, lsum, R, o);
#pragma unroll
        for (int c = 0; c < 2; ++c) {
            u32x4 pk;
            pk.x = pk2(pw[2 * c][0], pw[2 * c][1]); pk.y = pk2(pw[2 * c][2], pw[2 * c][3]);
            pk.z = pk2(pw[2 * c + 1][0], pw[2 * c + 1][1]); pk.w = pk2(pw[2 * c + 1][2], pw[2 * c + 1][3]);
            const bf16x8 pf = __builtin_bit_cast(bf16x8, pk);
#pragma unroll
            for (int dt = 0; dt < 4; ++dt) {
                const unsigned co = (unsigned)(((dt * 2 + (pp >> 1)) ^ vf_) << 4);
                const s16x4 lo = __builtin_amdgcn_ds_read_tr16_b64_v4i16((LAS s16x4*)(sV + (2 * c) * 2048 + vbase + co));
                const s16x4 hi = __builtin_amdgcn_ds_read_tr16_b64_v4i16((LAS s16x4*)(sV + (2 * c + 1) * 2048 + vbase + co));
                const bf16x8 vf = __builtin_shufflevector(lo, hi, 0, 1, 2, 3, 4, 5, 6, 7);
                o[dt] = __builtin_amdgcn_mfma_f32_16x16x32_bf16(vf, pf, o[dt], 0, 0, 0);
            }
        }
        }
        if (MODE == 0) {
            const bool sat = (wave * 16 >= a.nq) || (__builtin_amdgcn_ballot_w64(R < -104.0f) == ~0ull);
            if (lane == 0) *(LAS unsigned*)(lds + 2 * ASTG + (it & 1) * 64 + wave * 4) = sat ? 1u : 0u;
        }
        if (MODE == 2 && tid < 64 && it + 1 < a.ntiles) *(LAS float*)(lds + (st_ ^ 1) * ASTG + FOFF + tid * 4) = fnext;
    }
#undef ASTAGE
    float inv = 1.0f;
    if (MODE != 0) {
        { float a, b; swap16(lsum, a, b); lsum = a + b; swap32(lsum, a, b); lsum = a + b; }
        inv = 1.0f / lsum;
    }
    if (qi < a.nq) {
#pragma unroll
        for (int dt = 0; dt < 4; ++dt) *(f32x4*)(a.O + (size_t)qi * 1024 + dt * 16 + q * 4) = o[dt] * inv;
    }
}

DI void attn_phase(const Params& p, int bid, int nb, char* smem, const int tid) {
    const bf16_t* QA = (const bf16_t*)(p.ws + B_QA); const bf16_t* QC = (const bf16_t*)(p.ws + B_QC); const bf16_t* QB = (const bf16_t*)(p.ws + B_QB);
    const bf16_t* KA = (const bf16_t*)(p.ws + B_KA); const bf16_t* VA = (const bf16_t*)(p.ws + B_VA);
    const bf16_t* KC = (const bf16_t*)(p.ws + B_KC); const bf16_t* VC = (const bf16_t*)(p.ws + B_VC);
    const bf16_t* KVB = (const bf16_t*)(p.ws + B_KVB); const bf16_t* KR = (const bf16_t*)(p.ws + B_KR);
    const float* Fall = (const float*)(p.ws + B_F);
    float* O = (float*)(p.ws + B_Y);
    const bool xmap = nb == 256;
    const int nrounds = xmap ? 9 : (128 + 2048 + nb - 1) / nb;
    for (int rnd = 0; rnd < nrounds; ++rnd) {
        int b, hs, qrow0, krow0, nq, qpos0, Tk, nt;
        if (xmap) {
            if (rnd < 8) {
                const int i = bid >> 3;
                int qb;
                if (rnd < 2) {
                    const int pi = i & 3;
                    hs = (i >> 2) & 3;
                    qb = i < 16 ? (rnd == 0 ? pi : 11 - pi) : (rnd == 0 ? 15 - pi : 4 + pi);
                } else {
                    const int L = ((i & 15) + 4 * (rnd >> 1)) & 15;
                    qb = (rnd & 1) ? 15 - L : L;
                    hs = 2 * rnd + (i >> 4);
                }
                b = bid & 7;
                qrow0 = b * SEQ + qb * 128; krow0 = b * SEQ; nq = 128; qpos0 = qb * 128; Tk = SEQ; nt = 2 * qb + 2;
            } else {
                if (bid >= 128) continue;
                b = bid & 7; hs = bid >> 3;
                qrow0 = NP + b * TS; krow0 = NP + b * TKS; nq = TS; qpos0 = PAST; Tk = TKS; nt = 17;
            }
        } else {
            const int k = rnd * nb + ((rnd & 1) ? (nb - 1 - bid) : bid);
            if (k >= 128 + 2048) continue;
            if (k >= 1024 && k < 1152) { const int it = k - 1024; b = it >> 4; hs = it & 15; qrow0 = NP + b * TS; krow0 = NP + b * TKS; nq = TS; qpos0 = PAST; Tk = TKS; nt = 17; }
            else { const int j = k < 1024 ? k : k - 128; const int qb = 15 - (j >> 7); b = (j >> 4) & 7; hs = ((j & 15) + 5 * (j >> 7)) & 15; qrow0 = b * SEQ + qb * 128; krow0 = b * SEQ; nq = 128; qpos0 = qb * 128; Tk = SEQ; nt = 2 * qb + 2; }
        }
        AttnItem a;
        a.nq = nq; a.qpos0 = qpos0; a.Tk = Tk; a.ntiles = nt; a.KR = nullptr; a.F = nullptr;
        if (hs < 8) {
            a.Q = QB + (size_t)qrow0 * 768 + hs * 96; a.ldq = 768;
            a.K = KVB + (size_t)krow0 * 1024 + hs * 128; a.ldk = 1024; a.KR = KR + (size_t)krow0 * 32;
            a.V = KVB + (size_t)krow0 * 1024 + hs * 128 + 64; a.ldv = 1024;
            a.O = O + (size_t)qrow0 * 1024 + 256 + hs * 64;
            attn_item<1>(a, smem, tid);
        } else if (hs < 12) {
            const int h = hs - 8;
            a.Q = QA + (size_t)qrow0 * 256 + h * 64; a.ldq = 256;
            a.K = KA + (size_t)krow0 * 256 + h * 64; a.ldk = 256;
            a.V = VA + (size_t)krow0 * 256 + h * 64; a.ldv = 256;
            a.O = O + (size_t)qrow0 * 1024 + h * 64;
            attn_item<0>(a, smem, tid);
        } else {
            const int h = hs - 12;
            a.Q = QC + (size_t)qrow0 * 256 + h * 64; a.ldq = 256;
            a.K = KC + (size_t)krow0 * 256 + h * 64; a.ldk = 256;
            a.V = VC + (size_t)krow0 * 256 + h * 64; a.ldv = 256;
            a.F = Fall + (size_t)krow0 * 4 + h;
            a.O = O + (size_t)qrow0 * 1024 + 768 + h * 64;
            attn_item<2>(a, smem, tid);
        }
    }
}


#define XB_TMO      128
#define XB_XCNT(j)  (256  + 64 * (j))
#define XB_XSUB(j)  (1280 + 64 * (j))
#define XB_XGEN(j)  (2304 + 64 * (j))
#define XB_TOP      3328
#define XB_TOPGEN   3392
#define XCD_BAR_WORDS 3456
#define XB_SPIN_CAP (1u << 22)
DI unsigned xb_ld(unsigned* p) { return __hip_atomic_load(p, __ATOMIC_RELAXED, __HIP_MEMORY_SCOPE_AGENT); }
DI unsigned xb_add(unsigned* p, unsigned v) { return __hip_atomic_fetch_add(p, v, __ATOMIC_RELAXED, __HIP_MEMORY_SCOPE_AGENT); }
DI unsigned xb_xcc_id() { return (unsigned)__builtin_amdgcn_s_getreg((3 << 11) | 20) & 0xFu; }
#define XB_SPIN(cond, bar) do { unsigned _sp = 0; while (cond) { __builtin_amdgcn_s_sleep(1); \
    if ((++_sp & 255u) == 0u) { if (xb_ld(&(bar)[XB_TMO])) break; if (_sp > XB_SPIN_CAP) { atomicAdd(&(bar)[XB_TMO], 1u); break; } } } } while (0)
struct XcdBarrier { unsigned* bar; unsigned x; volatile LAS unsigned* st; };
DI XcdBarrier xcd_barrier_post(unsigned* bar, volatile LAS unsigned* st) {
    XcdBarrier b; b.bar = bar; b.x = xb_xcc_id(); b.st = st;
    if (threadIdx.x == 0) (void)xb_add(&bar[XB_XCNT(b.x)], 1u);
    return b;
}
DI void xcd_barrier_complete(unsigned* bar, unsigned x, unsigned& nloc, unsigned& nx) {
    const unsigned G = gridDim.x * gridDim.y * gridDim.z;
    unsigned sum, cnt, mine, sp = 0u;
    for (;;) {
        sum = 0u; cnt = 0u; mine = 0u;
#pragma unroll
        for (unsigned j = 0; j < 16; ++j) { const unsigned c = xb_ld(&bar[XB_XCNT(j)]); sum += c; cnt += (c > 0u) ? 1u : 0u; mine = (j == x) ? c : mine; }
        if (sum == G) break;
        __builtin_amdgcn_s_sleep(1);
        if ((++sp & 255u) == 0u) { if (xb_ld(&bar[XB_TMO])) break; if (sp > XB_SPIN_CAP) { atomicAdd(&bar[XB_TMO], 1u); break; } }
    }
    nloc = mine > 0u ? mine : 1u; nx = cnt > 0u ? cnt : 1u;
}
DI void xcd_barrier(const XcdBarrier& b) {
    asm volatile("s_waitcnt vmcnt(0)" ::: "memory");
    __syncthreads();
    if (threadIdx.x == 0) {
        unsigned* bar = b.bar;
        __builtin_amdgcn_s_waitcnt(0);
        unsigned nloc = b.st[0], nx = b.st[1];
        if (nloc == 0u) { xcd_barrier_complete(bar, b.x, nloc, nx); b.st[0] = nloc; b.st[1] = nx; }
        const unsigned old = xb_add(&bar[XB_XSUB(b.x)], 1u);
        const unsigned gen = old / nloc;
        if (old + 1u == (gen + 1u) * nloc) {
            __builtin_amdgcn_fence(__ATOMIC_RELEASE, "agent");
            asm volatile("s_waitcnt vmcnt(0)" ::: "memory");
            const unsigned og = xb_add(&bar[XB_TOP], 1u);
            const unsigned tg = og / nx;
            if (og + 1u == (tg + 1u) * nx) xb_add(&bar[XB_TOPGEN], 1u);
            else XB_SPIN(xb_ld(&bar[XB_TOPGEN]) == tg, bar);
            __builtin_amdgcn_fence(__ATOMIC_ACQUIRE, "agent");
            xb_add(&bar[XB_XGEN(b.x)], 1u);
            asm volatile("s_waitcnt vmcnt(0)" ::: "memory");
        } else {
            XB_SPIN(xb_ld(&bar[XB_XGEN(b.x)]) == gen, bar);
            __builtin_amdgcn_fence(__ATOMIC_ACQUIRE, "agent");
            asm volatile("s_waitcnt vmcnt(0)" ::: "memory");
        }
    }
    __syncthreads();
}

constexpr int NPHASE = 31;
DI void run_phase(const Params& pk, int ph, int bid_, int nb, char* smem) {
    int tid = threadIdx.x; asm volatile("" : "+v"(tid));
    int bid = bid_; asm volatile("" : "+s"(bid));
    Params p = pk;
    asm volatile("" : "+s"(p.ws));
    asm volatile("" : "+s"(p.out));
    if (ph == 0) {
        prep_phase(p, 0, bid, nb, smem, tid);
        rowpass(p, true, 0.f, nullptr, p.in[11], 1, bid, nb, tid);
        return;
    }
    const int l = (ph - 1) / 15, s = (ph - 1) % 15;
    switch (s) {
    case 0: gemm_gu(p, W_GU1, bid, nb, smem, tid); break;
    case 1: gemm_y(p, (const bf16_t*)(p.ws + B_ACT), DFF, W_DN1, DFF, 4, bid, nb, smem, tid); break;
    case 2: rowpass(p, false, 0.5f, p.in[12] + l * DM, p.in[15] + l * DM, 11, bid, nb, tid); break;
    case 3: gemm_in(p, l, bid, nb, smem, tid); break;
    case 4: post_phase(p, l, bid, nb, tid); break;
    case 5: gemm_uqkv(p, bid, nb, smem, tid); break;
    case 6: attn_phase(p, bid, nb, smem, tid); break;
    case 7: onorm_pass(p, p.in[23] + l * DM, bid, nb, tid); break;
    case 8: gemm_y(p, (const bf16_t*)(p.ws + B_XN), DM, W_OUT, DM, 2, bid, nb, smem, tid); break;
    case 9: rowpass(p, false, 1.0f, p.in[16] + l * DM, p.in[25] + l * DM, 8, bid, nb, tid); break;
    case 10: gemm_gu(p, W_GU2, bid, nb, smem, tid); break;
    case 11: gemm_y(p, (const bf16_t*)(p.ws + B_ACT), DFF, W_DN2, DFF, 4, bid, nb, smem, tid); break;
    case 12: rowpass(p, false, 0.5f, p.in[26] + l * DM, p.in[29] + l * DM, 11, bid, nb, tid); break;
    case 13: gemm_ple(p, bid, nb, smem, tid); break;
    case 14:
        rowpass(p, false, 1.0f, p.in[32] + l * DM, l == 0 ? p.in[11] + DM : nullptr, 1, bid, nb, tid);
        if (l == 0) prep_phase(p, 1, bid, nb, smem, tid);
        break;
    }
}

extern "C" __global__ void __launch_bounds__(512, 2) fwd_kernel(Params p, int ph0, int ph1) {
    extern __shared__ __attribute__((aligned(16))) char smem[];
#if MEGA
    __shared__ uint4 xb_words;
    if (threadIdx.x == 0) xb_words = make_uint4(0u, 0u, 0u, 0u);
    __syncthreads();
    XcdBarrier xb = xcd_barrier_post((unsigned*)(p.ws + B_BAR), (volatile LAS unsigned*)&xb_words);
    if (ph1 > 100000) cg::this_grid().sync();
#ifdef PROBE_DUP
    for (int pp = 2 * ph0; pp < 2 * ph1; ++pp) {
        const int ph = pp >> 1;
        if ((pp & 1) && !((ph > 0 && ((PROBE_DUP >> ((ph - 1) % 15)) & 1)) || (ph == 0 && (PROBE_DUP >> 20)))) continue;
        run_phase(p, ph, blockIdx.x, gridDim.x, smem);
        xcd_barrier(xb);
    }
#else
    for (int ph = ph0; ph < ph1; ++ph) {
        run_phase(p, ph, blockIdx.x, gridDim.x, smem);
        if (ph + 1 < ph1) xcd_barrier(xb);
    }
#endif
#else
    for (int ph = ph0; ph < ph1; ++ph) run_phase(p, ph, blockIdx.x, gridDim.x, smem);
#endif
}

extern "C" void kernel_launch(void* const* d_in, const int* in_sizes, int n_in, void* d_out, int out_size, void* d_ws, size_t ws_size, hipStream_t stream) {
    static int grid_blocks = 0;
    if (!grid_blocks) {
        int dev = 0, cus = 0, per_cu = 0;
        hipGetDevice(&dev);
        hipDeviceGetAttribute(&cus, hipDeviceAttributeMultiprocessorCount, dev);
        hipFuncSetAttribute((const void*)fwd_kernel, hipFuncAttributeMaxDynamicSharedMemorySize, LDS_BYTES);
        hipOccupancyMaxActiveBlocksPerMultiprocessor(&per_cu, fwd_kernel, NTHR, LDS_BYTES);
        if (per_cu < 1) per_cu = 1;
        if (per_cu > 1) per_cu = 1;
        grid_blocks = cus * per_cu;
    }
    if (ws_size < WS_TOTAL) { fprintf(stderr, "workspace too small: %zu < %zu\n", ws_size, (size_t)WS_TOTAL); return; }
    Params p{};
    for (int i = 0; i < 33; ++i) p.in[i] = (const float*)d_in[i];
    p.out = (float*)d_out;
    p.ws = (char*)d_ws;
#if MEGA
    hipMemsetAsync((char*)d_ws + B_BAR, 0, XCD_BAR_WORDS * 4, stream);
    int ph0 = 0, ph1 = NPHASE;
    void* args[] = {&p, &ph0, &ph1};
    hipError_t e = hipLaunchCooperativeKernel((const void*)fwd_kernel, dim3(grid_blocks), dim3(NTHR), args, LDS_BYTES, stream);
    if (e != hipSuccess) fprintf(stderr, "cooperative launch failed: %s (grid %d)\n", hipGetErrorString(e), grid_blocks);
#else
    for (int ph = 0; ph < NPHASE; ++ph) hipLaunchKernelGGL(fwd_kernel, dim3(grid_blocks), dim3(NTHR), LDS_BYTES, stream, p, ph, ph + 1);
#endif
}
```
